# Optimizing an MI355X kernel written in HIP

```python
import jax, jax.numpy as jnp
from jax import lax
import numpy as np

D_MODEL = 2048
BATCH = 4
SEQ = 2048
DEPTH = 2

N_META = 16
CHUNK = 64
Q_BLOCK = 128
CONV_K = 4
EPS = 1e-6

A_HEADS = 4
A_DK = 128
A_DV = D_MODEL // (2 * A_HEADS)
B_HEADS = 4
B_DK = 128
B_DV = D_MODEL // (2 * B_HEADS)
GATE_RANK = 16
GATE_TAU = 16.0
C_HEADS = 8
C_DK = 128
C_DV = D_MODEL // (2 * C_HEADS)
D_HEADS = 8
D_NOPE = 128
D_ROPE = 64
D_V = D_MODEL // (2 * D_HEADS)
Q_LORA = 512
KV_LORA = 256
ROPE_THETA = 10000.0
N_GROUPS = 4
EXPERTS_PER_GROUP = 8
N_EXPERTS = N_GROUPS * EXPERTS_PER_GROUP
TOP_K = 2
D_EXPERT = 512
MOE_BLOCK = 128

N_EVEN = (DEPTH + 1) // 2
N_ODD = DEPTH // 2

EVEN_SPLITS = (A_HEADS * A_DK, A_HEADS * A_DK, A_HEADS * A_DV, A_HEADS * A_DV, A_HEADS, A_HEADS,
               B_HEADS * B_DK, B_HEADS * B_DK, B_HEADS * B_DV, B_HEADS * B_DV, GATE_RANK)
ODD_SPLITS = (C_HEADS * C_DK, C_HEADS * C_DK, C_HEADS * C_DV, C_HEADS * C_DV, Q_LORA, KV_LORA, D_ROPE)

kernel_name = "hybrid_mlstm_gla_hgrn2_mla_hmoe"

F32 = jnp.float32


def rms_norm(u, g):
    uf = u.astype(F32)
    y = uf * lax.rsqrt(jnp.mean(uf * uf, axis=-1, keepdims=True) + EPS)
    return (y * g.astype(F32)).astype(u.dtype)


def head_rms_norm(u, g, n_heads):
    B, T, W = u.shape
    y = rms_norm(u.reshape(B, T, n_heads, W // n_heads), g.reshape(n_heads, W // n_heads))
    return y.reshape(B, T, W)


def split_cols(z, sizes):
    offs = np.cumsum(np.array(sizes))[:-1].tolist()
    return jnp.split(z, offs, axis=-1)


def to_heads(u, n_heads):
    B, T, W = u.shape
    return u.reshape(B, T, n_heads, W // n_heads).transpose(0, 2, 1, 3)


def from_heads(u):
    B, H, T, d = u.shape
    return u.transpose(0, 2, 1, 3).reshape(B, T, H * d)


def meta_and_chunks(u):
    B, H = u.shape[:2]
    rest = u.shape[3:]
    meta = u[:, :, :N_META].reshape(B, H, 1, N_META, *rest)
    real = u[:, :, N_META:].reshape(B, H, -1, CHUNK, *rest)
    return meta, real


def join_chunks(meta, real):
    B, H = meta.shape[:2]
    d = meta.shape[-1]
    return jnp.concatenate([meta.reshape(B, H, -1, d), real.reshape(B, H, -1, d)], axis=2)


def causal_conv(u, w, b):
    T = u.shape[1]
    up = jnp.pad(u, ((0, 0), (CONV_K - 1, 0), (0, 0)))
    y = b
    for j in range(CONV_K):
        y = y + up[:, j:j + T] * w[j]
    return y


def mlstm_chunks(q, k, v, ig, lf, state):
    L = q.shape[3]
    b = jnp.cumsum(lf, axis=-1)
    b_end = b[..., -1]
    w_end = b_end[..., None] - b + ig
    m_loc = jnp.max(w_end, axis=-1)
    k_w = k * jnp.exp(w_end - m_loc[..., None])[..., None]
    C_loc = jnp.einsum('bhcsk,bhcsv->bhckv', k_w, v)
    n_loc = jnp.sum(k_w, axis=3)

    def step(carry, inp):
        C, n, m = carry
        Cl, nl, ml, bl = inp
        m_new = jnp.maximum(bl + m, ml)
        a = jnp.exp(bl + m - m_new)
        c = jnp.exp(ml - m_new)
        new = (a[..., None, None] * C + c[..., None, None] * Cl, a[..., None] * n + c[..., None] * nl, m_new)
        return new, (C, n, m)

    xs = (jnp.moveaxis(C_loc, 2, 0), jnp.moveaxis(n_loc, 2, 0), jnp.moveaxis(m_loc, 2, 0), jnp.moveaxis(b_end, 2, 0))
    final, (C_in, n_in, m_in) = lax.scan(step, state, xs)
    C_in = jnp.moveaxis(C_in, 0, 2)
    n_in = jnp.moveaxis(n_in, 0, 2)
    m_in = jnp.moveaxis(m_in, 0, 2)

    causal = jnp.tril(jnp.ones((L, L), dtype=bool))
    d = jnp.where(causal, b[..., :, None] - b[..., None, :] + ig[..., None, :], -jnp.inf)
    inter = b + m_in[..., None]
    m_t = jnp.maximum(inter, jnp.max(d, axis=-1))
    s = jnp.einsum('bhctk,bhcsk->bhcts', q, k) * jnp.exp(d - m_t[..., None])
    a_t = jnp.exp(inter - m_t)
    num = jnp.einsum('bhcts,bhcsv->bhctv', s, v) + a_t[..., None] * jnp.einsum('bhctk,bhckv->bhctv', q, C_in)
    den = jnp.sum(s, axis=-1) + a_t * jnp.einsum('bhctk,bhck->bhct', q, n_in)
    h = num / jnp.maximum(jnp.abs(den), jnp.exp(-m_t))[..., None]
    return h, final


def gla_chunks(q, k, v, lg, state):
    L = q.shape[3]
    g = jnp.cumsum(lg, axis=3)
    g_end = g[:, :, :, -1]
    g_ref = g[:, :, :, L // 2][:, :, :, None]
    q_in = q * jnp.exp(g - g_ref)
    k_in = k * jnp.exp(g_ref - g)
    causal = jnp.tril(jnp.ones((L, L), dtype=bool))
    s = jnp.where(causal, jnp.einsum('bhctk,bhcsk->bhcts', q_in, k_in), 0.0)
    intra = jnp.einsum('bhcts,bhcsv->bhctv', s, v)
    S_loc = jnp.einsum('bhcsk,bhcsv->bhckv', k * jnp.exp(g_end[:, :, :, None] - g), v)
    decay = jnp.exp(g_end)

    def step(S, inp):
        dc, Sl = inp
        return dc[..., None] * S + Sl, S

    final, S_in = lax.scan(step, state, (jnp.moveaxis(decay, 2, 0), jnp.moveaxis(S_loc, 2, 0)))
    S_in = jnp.moveaxis(S_in, 0, 2)
    inter = jnp.einsum('bhctk,bhckv->bhctv', q * jnp.exp(g), S_in)
    return intra + inter, final


def run_mlstm(q, k, v, ig, lf):
    B, H, T, dk = q.shape
    dv = v.shape[-1]
    state = (jnp.zeros((B, H, dk, dv), F32), jnp.zeros((B, H, dk), F32), jnp.zeros((B, H), F32))
    metas, reals = zip(*[meta_and_chunks(u) for u in (q, k, v, ig, lf)])
    h_meta, state = mlstm_chunks(*metas, state)
    h_real, _ = mlstm_chunks(*reals, state)
    return join_chunks(h_meta, h_real)


def run_gla(q, k, v, lg):
    B, H, T, dk = q.shape
    dv = v.shape[-1]
    state = jnp.zeros((B, H, dk, dv), F32)
    metas, reals = zip(*[meta_and_chunks(u) for u in (q, k, v, lg)])
    o_meta, state = gla_chunks(*metas, state)
    o_real, _ = gla_chunks(*reals, state)
    return join_chunks(o_meta, o_real)


def rope(u, pos):
    half = u.shape[-1] // 2
    inv = ROPE_THETA ** (-jnp.arange(half, dtype=F32) / half)
    ang = pos[:, None] * inv[None, :]
    cos = jnp.cos(ang)[:, None, :].astype(u.dtype)
    sin = jnp.sin(ang)[:, None, :].astype(u.dtype)
    u1, u2 = u[..., :half], u[..., half:]
    return jnp.concatenate([u1 * cos - u2 * sin, u1 * sin + u2 * cos], axis=-1)


def block_causal_attention(q, k, v):
    B, T, H, dqk = q.shape
    nb = -(-T // Q_BLOCK)
    Tp = nb * Q_BLOCK
    qb = jnp.pad(q, ((0, 0), (0, Tp - T), (0, 0), (0, 0))).reshape(B, nb, Q_BLOCK, H, dqk).transpose(1, 0, 2, 3, 4)
    kpos = jnp.arange(T)
    scale = dqk ** -0.5

    def one_block(args):
        qi, bi = args
        s = jnp.einsum('bqhd,bkhd->bhqk', qi, k).astype(F32) * scale
        qpos = bi * Q_BLOCK + jnp.arange(Q_BLOCK)
        s = jnp.where(kpos[None, :] <= qpos[:, None], s, -jnp.inf)
        p = jax.nn.softmax(s, axis=-1).astype(v.dtype)
        return jnp.einsum('bhqk,bkhd->bqhd', p, v)

    o = lax.map(one_block, (qb, jnp.arange(nb)))
    return o.transpose(1, 0, 2, 3, 4).reshape(B, Tp, H, -1)[:, :T]


def mla(cq, ckv, kr, pos, q_a_norm, w_q_up, kv_a_norm, w_kv_up, q_norm, k_norm):
    B, T, _ = cq.shape
    q = (rms_norm(cq, q_a_norm) @ w_q_up).reshape(B, T, D_HEADS, D_NOPE + D_ROPE)
    kv = (rms_norm(ckv, kv_a_norm) @ w_kv_up).reshape(B, T, D_HEADS, D_NOPE + D_V)
    k = jnp.concatenate([kv[..., :D_NOPE], jnp.broadcast_to(kr[:, :, None, :], (B, T, D_HEADS, D_ROPE))], axis=-1)
    q = rms_norm(q, q_norm)
    k = rms_norm(k, k_norm)
    q = jnp.concatenate([q[..., :D_NOPE], rope(q[..., D_NOPE:], pos)], axis=-1)
    k = jnp.concatenate([k[..., :D_NOPE], rope(k[..., D_NOPE:], pos)], axis=-1)
    o = block_causal_attention(q, k, kv[..., D_NOPE:])
    return o.reshape(B, T, D_HEADS * D_V)


def even_layer(x, norm_g, w_in, conv_w, conv_b, b_i, b_f, a_norm, w_gate2, b_gate, b_norm, w_out):
    h = rms_norm(x, norm_g)
    aq, ak, av, ao, ai, af, bq, bk, bv, bg, ba = split_cols(h @ w_in, EVEN_SPLITS)
    qk = jax.nn.silu(causal_conv(jnp.concatenate([aq, ak], axis=-1), conv_w, conv_b))
    aq, ak = qk[..., :A_HEADS * A_DK], qk[..., A_HEADS * A_DK:]
    ig = (ai.astype(F32) + b_i).transpose(0, 2, 1)
    lf = jax.nn.log_sigmoid(af.astype(F32) + b_f).transpose(0, 2, 1)
    ha = run_mlstm(to_heads(aq, A_HEADS), to_heads(ak, A_HEADS) * (A_DK ** -0.5), to_heads(av, A_HEADS), ig, lf)
    ya = jax.nn.sigmoid(ao) * head_rms_norm(from_heads(ha).astype(x.dtype), a_norm, A_HEADS)
    lg = jax.nn.log_sigmoid((ba @ w_gate2).astype(F32) + b_gate) / GATE_TAU
    hb = run_gla(to_heads(bq, B_HEADS) * (B_DK ** -0.5), to_heads(bk, B_HEADS), to_heads(bv, B_HEADS), to_heads(lg, B_HEADS))
    yb = jax.nn.silu(bg) * head_rms_norm(from_heads(hb).astype(x.dtype), b_norm, B_HEADS)
    return x + jnp.concatenate([ya, yb], axis=-1) @ w_out


def odd_layer(x, pos, lb, norm_g, w_in, c_norm, q_a_norm, w_q_up, kv_a_norm, w_kv_up, q_norm, k_norm, w_out):
    h = rms_norm(x, norm_g)
    cq, cf, ci, cg, dq, dkv, dkr = split_cols(h @ w_in, ODD_SPLITS)
    fpre = cf.astype(F32)
    lf = jnp.logaddexp(jnp.log(lb), jnp.log1p(-lb) + jax.nn.log_sigmoid(fpre))
    kc = (1.0 - lb) * jax.nn.sigmoid(-fpre)
    hc = run_gla(to_heads(cq, C_HEADS), to_heads(kc, C_HEADS), to_heads(ci, C_HEADS), to_heads(lf, C_HEADS))
    yc = jax.nn.sigmoid(cg) * head_rms_norm(from_heads(hc).astype(x.dtype), c_norm, C_HEADS)
    yd = mla(dq, dkv, dkr, pos, q_a_norm, w_q_up, kv_a_norm, w_kv_up, q_norm, k_norm)
    return x + jnp.concatenate([yc, yd], axis=-1) @ w_out


def hier_moe(h, w_group, b_group, w_expert, b_expert, w1, w3, w2):
    B, T, D = h.shape
    xf = h.reshape(-1, D)
    N = xf.shape[0]
    p_group = jax.nn.softmax((xf @ w_group).astype(F32) + b_group, axis=-1)
    p_top, grp = lax.top_k(p_group, 1)
    e_logits = ((xf @ w_expert).astype(F32) + b_expert).reshape(N, N_GROUPS, EXPERTS_PER_GROUP)
    e_sel = jnp.take_along_axis(e_logits, grp[:, :, None], axis=1)[:, 0]
    top_p, top_i = lax.top_k(jax.nn.softmax(e_sel, axis=-1), TOP_K)
    gates = p_top * top_p / jnp.sum(top_p, axis=-1, keepdims=True)
    expert_idx = grp * EXPERTS_PER_GROUP + top_i

    A = N * TOP_K
    n_blocks = -(-A // MOE_BLOCK) + N_EXPERTS
    P = n_blocks * MOE_BLOCK
    flat_e = expert_idx.reshape(-1)
    order = jnp.argsort(flat_e)
    sorted_e = flat_e[order]
    counts = jnp.bincount(flat_e, length=N_EXPERTS)
    padded = (counts + MOE_BLOCK - 1) // MOE_BLOCK * MOE_BLOCK
    pad_end = jnp.cumsum(padded)
    pad_start = pad_end - padded
    start = jnp.cumsum(counts) - counts
    dest = pad_start[sorted_e] + jnp.arange(A) - start[sorted_e]
    slot_token = jnp.full((P,), N, jnp.int32).at[dest].set((order // TOP_K).astype(jnp.int32))
    slot_gate = jnp.zeros((P,), gates.dtype).at[dest].set(gates.reshape(-1)[order])
    block_expert = jnp.minimum(jnp.searchsorted(pad_end, jnp.arange(n_blocks) * MOE_BLOCK, side='right'), N_EXPERTS - 1)
    xs = jnp.concatenate([xf, jnp.zeros((1, D), xf.dtype)], axis=0)[slot_token].reshape(n_blocks, MOE_BLOCK, D)

    def expert_block(args):
        xb, e = args
        return (jax.nn.silu(xb @ w1[e]) * (xb @ w3[e])) @ w2[e]

    ys = lax.map(expert_block, (xs, block_expert)).reshape(P, D)
    ys = ys * slot_gate[:, None].astype(ys.dtype)
    out = jnp.zeros((N + 1, D), ys.dtype).at[slot_token].add(ys)[:N]
    return out.reshape(B, T, D).astype(h.dtype)


def setup_inputs(seed: int = 0) -> dict:
    key = jax.random.key(seed)
    ks = iter(jax.random.split(key, 48))

    def normal(shape, scale):
        return scale * jax.random.normal(next(ks), shape, F32)

    def gain(shape):
        return 1.0 + normal(shape, 0.05)

    even_cols = sum(EVEN_SPLITS)
    odd_cols = sum(ODD_SPLITS)
    return {
        "x": normal((BATCH, SEQ, D_MODEL), 1.0),
        "meta_tokens": normal((N_META, D_MODEL), 1.0),
        "ab_norm": gain((N_EVEN, D_MODEL)),
        "ab_w_in": normal((N_EVEN, D_MODEL, even_cols), D_MODEL ** -0.5),
        "a_conv_w": normal((N_EVEN, CONV_K, 2 * A_HEADS * A_DK), CONV_K ** -0.5),
        "a_conv_b": normal((N_EVEN, 2 * A_HEADS * A_DK), 0.02),
        "a_b_i": normal((N_EVEN, A_HEADS), 0.1),
        "a_b_f": jnp.linspace(3.0, 6.0, A_HEADS, dtype=F32) + normal((N_EVEN, A_HEADS), 0.1),
        "a_head_norm": gain((N_EVEN, A_HEADS * A_DV)),
        "b_w_gate2": normal((N_EVEN, GATE_RANK, B_HEADS * B_DK), GATE_RANK ** -0.5),
        "b_b_gate": normal((N_EVEN, B_HEADS * B_DK), 0.1),
        "b_head_norm": gain((N_EVEN, B_HEADS * B_DV)),
        "ab_w_out": normal((N_EVEN, D_MODEL, D_MODEL), D_MODEL ** -0.5),
        "cd_norm": gain((N_ODD, D_MODEL)),
        "cd_w_in": normal((N_ODD, D_MODEL, odd_cols), D_MODEL ** -0.5),
        "c_lower_bound": normal((DEPTH, C_HEADS * C_DK), 0.5),
        "c_head_norm": gain((N_ODD, C_HEADS * C_DV)),
        "d_q_a_norm": gain((N_ODD, Q_LORA)),
        "d_w_q_up": normal((N_ODD, Q_LORA, D_HEADS * (D_NOPE + D_ROPE)), Q_LORA ** -0.5),
        "d_kv_a_norm": gain((N_ODD, KV_LORA)),
        "d_w_kv_up": normal((N_ODD, KV_LORA, D_HEADS * (D_NOPE + D_V)), KV_LORA ** -0.5),
        "d_q_norm": gain((N_ODD, D_NOPE + D_ROPE)),
        "d_k_norm": gain((N_ODD, D_NOPE + D_ROPE)),
        "cd_w_out": normal((N_ODD, D_MODEL, D_MODEL), D_MODEL ** -0.5),
        "moe_norm": gain((DEPTH, D_MODEL)),
        "moe_w_group": normal((DEPTH, D_MODEL, N_GROUPS), D_MODEL ** -0.5),
        "moe_b_group": normal((DEPTH, N_GROUPS), 0.01),
        "moe_w_expert": normal((DEPTH, D_MODEL, N_EXPERTS), D_MODEL ** -0.5),
        "moe_b_expert": normal((DEPTH, N_EXPERTS), 0.01),
        "moe_w1": normal((DEPTH, N_EXPERTS, D_MODEL, D_EXPERT), D_MODEL ** -0.5),
        "moe_w3": normal((DEPTH, N_EXPERTS, D_MODEL, D_EXPERT), D_MODEL ** -0.5),
        "moe_w2": normal((DEPTH, N_EXPERTS, D_EXPERT, D_MODEL), D_EXPERT ** -0.5),
    }


def reference(x, meta_tokens, ab_norm, ab_w_in, a_conv_w, a_conv_b, a_b_i, a_b_f, a_head_norm,
              b_w_gate2, b_b_gate, b_head_norm, ab_w_out, cd_norm, cd_w_in, c_lower_bound, c_head_norm,
              d_q_a_norm, d_w_q_up, d_kv_a_norm, d_w_kv_up, d_q_norm, d_k_norm, cd_w_out,
              moe_norm, moe_w_group, moe_b_group, moe_w_expert, moe_b_expert, moe_w1, moe_w3, moe_w2):
    B = x.shape[0]
    h = jnp.concatenate([jnp.broadcast_to(meta_tokens.astype(x.dtype)[None], (B, N_META, D_MODEL)), x], axis=1)
    T = h.shape[1]
    pos = jnp.arange(T, dtype=F32)
    lb_cum = jnp.cumsum(jax.nn.softmax(c_lower_bound.astype(F32), axis=0), axis=0)
    lower_bounds = lb_cum - lb_cum[0]
    for layer in range(DEPTH):
        j = layer // 2
        if layer % 2 == 0:
            h = even_layer(h, ab_norm[j], ab_w_in[j], a_conv_w[j], a_conv_b[j], a_b_i[j], a_b_f[j], a_head_norm[j],
                           b_w_gate2[j], b_b_gate[j], b_head_norm[j], ab_w_out[j])
        else:
            h = odd_layer(h, pos, lower_bounds[layer], cd_norm[j], cd_w_in[j], c_head_norm[j], d_q_a_norm[j],
                          d_w_q_up[j], d_kv_a_norm[j], d_w_kv_up[j], d_q_norm[j], d_k_norm[j], cd_w_out[j])
        h = h + hier_moe(rms_norm(h, moe_norm[layer]), moe_w_group[layer], moe_b_group[layer], moe_w_expert[layer],
                         moe_b_expert[layer], moe_w1[layer], moe_w3[layer], moe_w2[layer])
    return h[:, N_META:]
```

```cpp
#include <hip/hip_runtime.h>
#include <hip/hip_cooperative_groups.h>
#include <cstdio>
#include <cstdint>
namespace cg = cooperative_groups;

#define DEVI __device__ __forceinline__
typedef unsigned short bf16;
typedef short bf16x8 __attribute__((ext_vector_type(8)));
typedef short s16x4 __attribute__((ext_vector_type(4)));
typedef float f32x4 __attribute__((ext_vector_type(4)));
typedef float f32x16 __attribute__((ext_vector_type(16)));
typedef unsigned u32x4 __attribute__((ext_vector_type(4)));
typedef unsigned u32x2 __attribute__((ext_vector_type(2)));
#define LAS __attribute__((address_space(3)))

constexpr int NB = 4, SEQ = 2048, NMETA = 16, T = 2064, NTOK = NB * T, D = 2048, MPAD = 8320;
constexpr int ZLD0 = 6144, ZLD1 = 4992;
constexpr int TP = 2112;
constexpr float EPS = 1e-6f;
constexpr int NE = 32;
constexpr int NTHR = 256;
constexpr int LDS_BYTES = 79936;

constexpr size_t MiB = 1u << 20;
constexpr size_t WS_CTL = 0;
constexpr size_t WS_RSTD = 1 * MiB;
constexpr size_t WS_GATES = 2 * MiB;
constexpr size_t WS_TOKE = 4 * MiB;
constexpr size_t WS_LIST = 5 * MiB;
constexpr size_t WS_GLIST = 7 * MiB;
constexpr size_t WS_WPK = 9 * MiB;
constexpr size_t WS_H = 10 * MiB;
constexpr size_t WS_XN = 76 * MiB;
constexpr size_t WS_Z = 110 * MiB;
constexpr size_t WS_HRAW = 208 * MiB;
constexpr size_t WS_Y = 242 * MiB;
constexpr size_t WS_HBUF = 276 * MiB;
constexpr size_t WS_YMOE = 294 * MiB;
constexpr size_t WS_QRAW = 360 * MiB;
constexpr size_t WS_KVRAW = 386 * MiB;
constexpr size_t WS_QH = 420 * MiB;
constexpr size_t WS_KH = 446 * MiB;
constexpr size_t WS_VT = 472 * MiB;
constexpr size_t WS_WIN0 = 490 * MiB;
constexpr size_t WS_WOUT0 = 516 * MiB;
constexpr size_t WS_WIN1 = 525 * MiB;
constexpr size_t WS_WOUT1 = 546 * MiB;
constexpr size_t WS_WQ = 555 * MiB;
constexpr size_t WS_WKV = 557 * MiB;
constexpr size_t WS_W13 = 560 * MiB;
constexpr size_t WS_W2 = 694 * MiB;
constexpr size_t WS_PQK = 762 * MiB;
constexpr size_t WS_PVEC = 798 * MiB;
constexpr size_t WS_W13B = 800 * MiB;
constexpr size_t WS_W2B = 934 * MiB;
constexpr size_t WS_ZT = 1001 * MiB;
constexpr size_t WS_END = 1014 * MiB;

constexpr int CT_CNT = 0;
constexpr int CT_BAR = 1024;
constexpr int CT_SPLITZ = 512;
constexpr int CT_WQ = 64;
constexpr int CTL_BYTES = 32768;

struct Params {
  const float* in[32];
  float* out;
  unsigned char* ws;
  int ph_lo, ph_hi, flags, pad;
};

DEVI unsigned f2bf(float f) { unsigned u = __float_as_uint(f); return (u + 0x7fffu + ((u >> 16) & 1u)) >> 16; }
DEVI unsigned pk2(float lo, float hi) { return f2bf(lo) | (f2bf(hi) << 16); }
DEVI float bf2f(bf16 b) { return __uint_as_float(((unsigned)b) << 16); }
DEVI float bflo(unsigned u) { return __uint_as_float(u << 16); }
DEVI float bfhi(unsigned u) { return __uint_as_float(u & 0xffff0000u); }
DEVI float sigmoidf_(float x) { return 1.f / (1.f + __expf(-x)); }
DEVI float siluf_(float x) { return x / (1.f + __expf(-x)); }
DEVI float logsigmoidf_(float x) { return fminf(x, 0.f) - __logf(1.f + __expf(-fabsf(x))); }
DEVI f32x4 mfma16(bf16x8 a, bf16x8 b, f32x4 c) { return __builtin_amdgcn_mfma_f32_16x16x32_bf16(a, b, c, 0, 0, 0); }
DEVI f32x16 mfma32(bf16x8 a, bf16x8 b, f32x16 c) { return __builtin_amdgcn_mfma_f32_32x32x16_bf16(a, b, c, 0, 0, 0); }
DEVI bf16x8 u4_as_b8(u32x4 v) { return __builtin_bit_cast(bf16x8, v); }
DEVI s16x4 lds_tr16(const char* p) { return __builtin_amdgcn_ds_read_tr16_b64_v4i16((LAS s16x4*)(p)); }
DEVI bf16x8 cat4(s16x4 a, s16x4 b) { bf16x8 r; r[0] = a[0]; r[1] = a[1]; r[2] = a[2]; r[3] = a[3]; r[4] = b[0]; r[5] = b[1]; r[6] = b[2]; r[7] = b[3]; return r; }


#define XB_TMO      128
#define XB_XCNT(j)  (256  + 64 * (j))
#define XB_XSUB(j)  (1280 + 64 * (j))
#define XB_XGEN(j)  (2304 + 64 * (j))
#define XB_TOP      3328
#define XB_TOPGEN   3392
#define XCD_BAR_WORDS 3456
#define XB_SPIN_CAP (1u << 18)
DEVI unsigned xb_ld(unsigned* p)              { return __hip_atomic_load(p, __ATOMIC_RELAXED, __HIP_MEMORY_SCOPE_AGENT); }
DEVI unsigned xb_add(unsigned* p, unsigned v) { return __hip_atomic_fetch_add(p, v, __ATOMIC_RELAXED, __HIP_MEMORY_SCOPE_AGENT); }
DEVI unsigned xb_xcc_id() { return (unsigned)__builtin_amdgcn_s_getreg((3 << 11) | 20) & 0xFu; }
#define XB_SPIN(cond, bar) do { unsigned _sp = 0; while (cond) { __builtin_amdgcn_s_sleep(1); \
    if ((++_sp & 255u) == 0u) { if (xb_ld(&(bar)[XB_TMO])) break; if (_sp > XB_SPIN_CAP) { atomicAdd(&(bar)[XB_TMO], 1u); break; } } } } while (0)
struct XcdBarrier { unsigned* bar; unsigned x; volatile LAS unsigned* st; };
DEVI XcdBarrier xcd_barrier_post(unsigned* bar, volatile LAS unsigned* st) {
    XcdBarrier b; b.bar = bar; b.x = xb_xcc_id(); b.st = st;
    if (threadIdx.x == 0) (void)xb_add(&bar[XB_XCNT(b.x)], 1u);
    return b;
}
DEVI void xcd_barrier_complete(unsigned* bar, unsigned x, unsigned& nloc, unsigned& nx) {
    const unsigned G = gridDim.x * gridDim.y * gridDim.z;
    unsigned sum, cnt, mine, sp = 0u;
    for (;;) {
        sum = 0u; cnt = 0u; mine = 0u;
#pragma unroll
        for (unsigned j = 0; j < 16; ++j) { const unsigned c = xb_ld(&bar[XB_XCNT(j)]); sum += c; cnt += (c > 0u) ? 1u : 0u; mine = (j == x) ? c : mine; }
        if (sum == G) break;
        __builtin_amdgcn_s_sleep(1);
        if ((++sp & 255u) == 0u) { if (xb_ld(&bar[XB_TMO])) break; if (sp > XB_SPIN_CAP) { atomicAdd(&bar[XB_TMO], 1u); break; } }
    }
    nloc = mine > 0u ? mine : 1u; nx = cnt > 0u ? cnt : 1u;
}
DEVI void xcd_barrier(const XcdBarrier& b) {
    asm volatile("s_waitcnt vmcnt(0)" ::: "memory");
    __syncthreads();
    if (threadIdx.x == 0) {
        unsigned* bar = b.bar;
        __builtin_amdgcn_s_waitcnt(0);
        unsigned nloc = b.st[0], nx = b.st[1];
        if (nloc == 0u) { xcd_barrier_complete(bar, b.x, nloc, nx); b.st[0] = nloc; b.st[1] = nx; }
        const unsigned old = xb_add(&bar[XB_XSUB(b.x)], 1u);
        const unsigned gen = old / nloc;
        if (old + 1u == (gen + 1u) * nloc) {
            __builtin_amdgcn_fence(__ATOMIC_RELEASE, "agent");
            asm volatile("s_waitcnt vmcnt(0)" ::: "memory");
            const unsigned og = xb_add(&bar[XB_TOP], 1u);
            const unsigned tg = og / nx;
            if (og + 1u == (tg + 1u) * nx) xb_add(&bar[XB_TOPGEN], 1u);
            else XB_SPIN(xb_ld(&bar[XB_TOPGEN]) == tg, bar);
            __builtin_amdgcn_fence(__ATOMIC_ACQUIRE, "agent");
            xb_add(&bar[XB_XGEN(b.x)], 1u);
            asm volatile("s_waitcnt vmcnt(0)" ::: "memory");
        } else {
            XB_SPIN(xb_ld(&bar[XB_XGEN(b.x)]) == gen, bar);
            __builtin_amdgcn_fence(__ATOMIC_ACQUIRE, "agent");
            asm volatile("s_waitcnt vmcnt(0)" ::: "memory");
        }
    }
    __syncthreads();
}

DEVI int next_item(int* ctr, int* lds_slot) {
  __syncthreads();
  if (threadIdx.x == 0) *lds_slot = atomicAdd(ctr, 1);
  __syncthreads();
  return *lds_slot;
}

DEVI int vcu_of(int bx, int G) { return (G % 8 == 0) ? (bx % 8) * (G / 8) + bx / 8 : bx; }

DEVI void transpose_tile(const float* __restrict__ src, int ldsrc, int k0, int c0, int nrel0, bf16* __restrict__ dst, int ldd, int roff, bool il,
                         const float* __restrict__ kscale, char* lds) {
  float* tile = (float*)lds;
  const int tid = threadIdx.x;
  {
    const int col = tid & 63, kr = tid >> 6;
#pragma unroll
    for (int i = 0; i < 16; ++i) {
      const int k = kr + 4 * i;
      float v = src[(size_t)(k0 + k) * ldsrc + c0 + col];
      if (kscale) v *= kscale[k0 + k];
      tile[col * 65 + k] = v;
    }
  }
  __syncthreads();
  {
    const int n = tid >> 2, kq = tid & 3;
    const float* s = tile + n * 65 + 16 * kq;
    u32x4 o0, o1;
    o0.x = pk2(s[0], s[1]); o0.y = pk2(s[2], s[3]); o0.z = pk2(s[4], s[5]); o0.w = pk2(s[6], s[7]);
    o1.x = pk2(s[8], s[9]); o1.y = pk2(s[10], s[11]); o1.z = pk2(s[12], s[13]); o1.w = pk2(s[14], s[15]);
    const int nr = nrel0 + n;
    const int drow = il ? ((nr >> 4) * 32 + (nr & 15) + roff) : (nr + roff);
    bf16* d = dst + (size_t)drow * ldd + k0 + 16 * kq;
    *(u32x4*)d = o0; *(u32x4*)(d + 8) = o1;
  }
  __syncthreads();
}

DEVI void transpose_job_tile(const float* src, int ldsrc, int coff, int ncols, int K, bf16* dst, int roff, bool il, const float* kscale, int tidx, char* lds) {
  const int nt = ncols / 64;
  const int kt = tidx / nt, ntile = tidx % nt;
  transpose_tile(src, ldsrc, kt * 64, coff + ntile * 64, ntile * 64, dst, K, roff, il, kscale, lds);
}

constexpr int TJ0 = 1536, TJ1 = 1536, TJ2 = 1024, TJ3 = 2464, TJ4 = 1024, TJ5 = 192, TJ6 = 128;
constexpr int TJ_DENSE = TJ0 + TJ1 + TJ2 + TJ3 + TJ4 + TJ5 + TJ6;
constexpr int TJ_MOE = 24576;

DEVI void dense_transposes(const Params& p, int vb, int G, char* lds) {
  unsigned char* ws = p.ws;
  for (int it = vb; it < TJ_DENSE; it += G) {
    int r = it;
    if (r < TJ0) { transpose_job_tile(p.in[3], 6168, 0, 3072, 2048, (bf16*)(ws + WS_WIN0), 0, false, nullptr, r, lds); continue; } r -= TJ0;
    if (r < TJ1) { transpose_job_tile(p.in[3], 6168, 3080, 3072, 2048, (bf16*)(ws + WS_WIN0), 3072, false, nullptr, r, lds); continue; } r -= TJ1;
    if (r < TJ2) { transpose_job_tile(p.in[12], 2048, 0, 2048, 2048, (bf16*)(ws + WS_WOUT0), 0, false, nullptr, r, lds); continue; } r -= TJ2;
    if (r < TJ3) { transpose_job_tile(p.in[14], 4928, 0, 4928, 2048, (bf16*)(ws + WS_WIN1), 0, false, nullptr, r, lds); continue; } r -= TJ3;
    if (r < TJ4) { transpose_job_tile(p.in[23], 2048, 0, 2048, 2048, (bf16*)(ws + WS_WOUT1), 0, false, nullptr, r, lds); continue; } r -= TJ4;
    if (r < TJ5) { transpose_job_tile(p.in[18], 1536, 0, 1536, 512, (bf16*)(ws + WS_WQ), 0, false, p.in[17], r, lds); continue; } r -= TJ5;
    transpose_job_tile(p.in[20], 2048, 0, 2048, 256, (bf16*)(ws + WS_WKV), 0, false, p.in[19], r, lds);
  }
  {
    bf16* w = (bf16*)(ws + WS_WIN1) + (size_t)4928 * 2048;
    const int n16 = 64 * 2048 / 8;
    for (int i = vb * NTHR + threadIdx.x; i < n16; i += G * NTHR) ((u32x4*)w)[i] = (u32x4){0u, 0u, 0u, 0u};
  }
}
DEVI void moe_transposes(const Params& p, int layer, int vb, int G, char* lds) {
  unsigned char* ws = p.ws;
  const size_t W13 = layer ? WS_W13B : WS_W13, W2 = layer ? WS_W2B : WS_W2;
  for (int it = vb; it < TJ_MOE; it += G) {
    const int e = it / 768; int r = it % 768;
    if (r < 256) { transpose_job_tile(p.in[29] + ((size_t)(layer * NE + e)) * 2048 * 512, 512, 0, 512, 2048, (bf16*)(ws + W13) + (size_t)e * 1024 * 2048, 0, true, nullptr, r, lds); continue; } r -= 256;
    if (r < 256) { transpose_job_tile(p.in[30] + ((size_t)(layer * NE + e)) * 2048 * 512, 512, 0, 512, 2048, (bf16*)(ws + W13) + (size_t)e * 1024 * 2048, 16, true, nullptr, r, lds); continue; } r -= 256;
    transpose_job_tile(p.in[31] + ((size_t)(layer * NE + e)) * 512 * 2048, 2048, 0, 2048, 512, (bf16*)(ws + W2) + (size_t)e * 2048 * 512, 0, false, nullptr, r, lds);
  }
}

struct FillState { int pos, end; bool active; };
DEVI void moe_tile(const Params& p, int git, char* lds) {
  unsigned char* ws = p.ws;
  const int layer = git >= TJ_MOE ? 1 : 0, it = git - layer * TJ_MOE;
  const size_t W13 = layer ? WS_W13B : WS_W13, W2 = layer ? WS_W2B : WS_W2;
  const int e = it / 768; int r = it % 768;
  if (r < 256) { transpose_job_tile(p.in[29] + ((size_t)(layer * NE + e)) * 2048 * 512, 512, 0, 512, 2048, (bf16*)(ws + W13) + (size_t)e * 1024 * 2048, 0, true, nullptr, r, lds); return; } r -= 256;
  if (r < 256) { transpose_job_tile(p.in[30] + ((size_t)(layer * NE + e)) * 2048 * 512, 512, 0, 512, 2048, (bf16*)(ws + W13) + (size_t)e * 1024 * 2048, 16, true, nullptr, r, lds); return; } r -= 256;
  transpose_job_tile(p.in[31] + ((size_t)(layer * NE + e)) * 512 * 2048, 2048, 0, 2048, 512, (bf16*)(ws + W2) + (size_t)e * 2048 * 512, 0, false, nullptr, r, lds);
}
DEVI bool fill_step(const Params& p, char* lds, FillState& f) {
  if (f.pos >= f.end) {
    if (!f.active) return false;
    int* ctr = (int*)(p.ws + WS_CTL) + CT_WQ + 48; int* slot = (int*)(lds + LDS_BYTES - 32);
    __syncthreads();
    if (threadIdx.x == 0) *slot = atomicAdd(ctr, 16);
    __syncthreads();
    f.pos = *slot; f.end = f.pos + 16;
    if (f.pos >= 2 * TJ_MOE) { f.active = false; f.end = f.pos; return false; }
  }
  moe_tile(p, f.pos, lds);
  ++f.pos;
  return true;
}

DEVI void pack_small(const Params& p, int vb, int G) {
  unsigned char* ws = p.ws;
  bf16* g0 = (bf16*)(ws + WS_WPK);
  bf16* r0 = (bf16*)(ws + WS_WPK + 131072);
  bf16* r1 = (bf16*)(ws + WS_WPK + 131072 + 196608);
  const int total = 64 * 2 * 64 + 2 * 64 * 3 * 64;
  for (int i = vb * NTHR + threadIdx.x; i < total; i += G * NTHR) {
    float v[8];
    bf16* dst;
    if (i < 64 * 2 * 64) {
      const int lane = i & 63, nb = (i >> 6) & 1, ks = i >> 7;
      const int n = 16 * nb + (lane & 15), k0 = 32 * ks + 8 * (lane >> 4);
      const int col = n < 8 ? 3072 + n : (n < 24 ? 6152 + (n - 8) : -1);
#pragma unroll
      for (int j = 0; j < 8; ++j) v[j] = col >= 0 ? p.in[3][(size_t)(k0 + j) * 6168 + col] : 0.f;
      dst = g0 + (size_t)i * 8;
    } else {
      int q = i - 64 * 2 * 64;
      const int layer = q / (64 * 3 * 64); q %= (64 * 3 * 64);
      const int lane = q & 63, nb = (q >> 6) % 3, ks = q / 192;
      const int n = 16 * nb + (lane & 15), k0 = 32 * ks + 8 * (lane >> 4);
#pragma unroll
      for (int j = 0; j < 8; ++j) {
        float x = 0.f;
        if (n < 4) x = p.in[25][((size_t)layer * 2048 + k0 + j) * 4 + n];
        else if (n < 36) x = p.in[27][((size_t)layer * 2048 + k0 + j) * 32 + (n - 4)];
        v[j] = x;
      }
      dst = (layer ? r1 : r0) + (size_t)q * 8;
    }
    u32x4 o; o.x = pk2(v[0], v[1]); o.y = pk2(v[2], v[3]); o.z = pk2(v[4], v[5]); o.w = pk2(v[6], v[7]);
    *(u32x4*)dst = o;
  }
}

DEVI void moe_offsets(const int* cnt, int* lds_off  , int* lds_tp  , int* lds_cnt  ) {
  if (threadIdx.x == 0) {
    int o = 0, t = 0;
    for (int e = 0; e < NE; ++e) { const int c = cnt[e]; lds_off[e] = o; lds_tp[e] = t; lds_cnt[e] = c; o += c; t += (c + 127) >> 7; }
    lds_off[NE] = o; lds_tp[NE] = t;
  }
  __syncthreads();
}

template <int MODE, int SMALL>
DEVI void rowpass(const Params& p, const float* __restrict__ gain, float* __restrict__ rstd_out, const bf16* __restrict__ wpk, int layer, int vb, int G, char* lds) {
  constexpr int NBK = SMALL == 1 ? 2 : (SMALL == 2 ? 3 : 0);
  constexpr int NA = NBK > 0 ? NBK : 1;
  unsigned char* ws = p.ws;
  bf16* hbuf = (bf16*)(ws + WS_H);
  bf16* xn = (bf16*)(ws + WS_XN);
  const bf16* ymoe = (const bf16*)(ws + WS_YMOE);
  int* ctl = (int*)(ws + WS_CTL);
  int* toke = (int*)(ws + WS_TOKE);
  const int tid = threadIdx.x, lane = tid & 63, wid = tid >> 6;
  float* part = (float*)lds;
  float* lgs = (float*)(lds + 24576);
  float* ssp = (float*)(lds + 29696);
  int* ioff = (int*)(lds + 30208);
  int* itp = ioff + 40; int* icnt = itp + 40;
  if (MODE == 1) moe_offsets(ctl + CT_CNT + layer * NE, ioff, itp, icnt);
  for (int it = vb; it < NTOK / 32; it += G) {
    const int kb = 512 * wid + 8 * (lane >> 4);
    const float* src[2]; const bf16* hsrc[2]; const bf16* y0[2]; const bf16* y1[2]; int rowf[2];
#pragma unroll
    for (int f = 0; f < 2; ++f) {
      const int row = 32 * it + 16 * f + (lane & 15);
      rowf[f] = row;
      if (MODE == 0) { const int b = row / T, t = row - b * T; src[f] = t < NMETA ? p.in[1] + (size_t)t * D : p.in[0] + ((size_t)b * SEQ + (t - NMETA)) * D; }
      else src[f] = nullptr;
      hsrc[f] = hbuf + (size_t)row * D;
      y0[f] = nullptr; y1[f] = nullptr;
      if (MODE == 1) {
        const int e0 = toke[row * 4 + 0], e1 = toke[row * 4 + 1], r0 = toke[row * 4 + 2], r1 = toke[row * 4 + 3];
        y0[f] = ymoe + (size_t)(ioff[e0] + r0) * D; y1[f] = ymoe + (size_t)(ioff[e1] + r1) * D;
      }
    }
    f32x4 acc[2][NA];
#pragma unroll
    for (int f = 0; f < 2; ++f)
#pragma unroll
      for (int n = 0; n < NA; ++n) acc[f][n] = (f32x4){0.f, 0.f, 0.f, 0.f};
    float ss[2] = {0.f, 0.f};
#pragma unroll 4
    for (int s = 0; s < 16; ++s) {
      const int k = kb + 32 * s;
      const f32x4 g0 = *(const f32x4*)(gain + k), g1 = *(const f32x4*)(gain + k + 4);
      bf16x8 xf[2];
#pragma unroll
      for (int f = 0; f < 2; ++f) {
        f32x4 a, b;
        if (MODE == 0) { a = *(const f32x4*)(src[f] + k); b = *(const f32x4*)(src[f] + k + 4); }
        else { const u32x4 hu = *(const u32x4*)(hsrc[f] + k);
          a[0] = bflo(hu.x); a[1] = bfhi(hu.x); a[2] = bflo(hu.y); a[3] = bfhi(hu.y); b[0] = bflo(hu.z); b[1] = bfhi(hu.z); b[2] = bflo(hu.w); b[3] = bfhi(hu.w); }
        if (MODE == 1) {
          const u32x4 u0 = *(const u32x4*)(y0[f] + k), u1 = *(const u32x4*)(y1[f] + k);
          a[0] += bflo(u0.x) + bflo(u1.x); a[1] += bfhi(u0.x) + bfhi(u1.x); a[2] += bflo(u0.y) + bflo(u1.y); a[3] += bfhi(u0.y) + bfhi(u1.y);
          b[0] += bflo(u0.z) + bflo(u1.z); b[1] += bfhi(u0.z) + bfhi(u1.z); b[2] += bflo(u0.w) + bflo(u1.w); b[3] += bfhi(u0.w) + bfhi(u1.w);
        }
        if (MODE != 2) {
          u32x4 hw; hw.x = pk2(a[0], a[1]); hw.y = pk2(a[2], a[3]); hw.z = pk2(b[0], b[1]); hw.w = pk2(b[2], b[3]);
          *(u32x4*)(hbuf + (size_t)rowf[f] * D + k) = hw;
          a[0] = bflo(hw.x); a[1] = bfhi(hw.x); a[2] = bflo(hw.y); a[3] = bfhi(hw.y); b[0] = bflo(hw.z); b[1] = bfhi(hw.z); b[2] = bflo(hw.w); b[3] = bfhi(hw.w);
        }
        ss[f] += (a[0] * a[0] + a[1] * a[1]) + (a[2] * a[2] + a[3] * a[3]) + (b[0] * b[0] + b[1] * b[1]) + (b[2] * b[2] + b[3] * b[3]);
        u32x4 o; o.x = pk2(a[0] * g0[0], a[1] * g0[1]); o.y = pk2(a[2] * g0[2], a[3] * g0[3]); o.z = pk2(b[0] * g1[0], b[1] * g1[1]); o.w = pk2(b[2] * g1[2], b[3] * g1[3]);
        *(u32x4*)(xn + (size_t)rowf[f] * D + k) = o;
        xf[f] = u4_as_b8(o);
      }
      if (NBK > 0) {
        const int ks = 16 * wid + s;
#pragma unroll
        for (int n = 0; n < NBK; ++n) {
          const bf16x8 wf = u4_as_b8(*(const u32x4*)(wpk + ((size_t)(ks * NBK + n) * 64 + lane) * 8));
#pragma unroll
          for (int f = 0; f < 2; ++f) acc[f][n] = mfma16(wf, xf[f], acc[f][n]);
        }
      }
    }
#pragma unroll
    for (int f = 0; f < 2; ++f) {
      float v = ss[f]; v += __shfl_xor(v, 16); v += __shfl_xor(v, 32);
      if (lane < 16) ssp[wid * 32 + 16 * f + lane] = v;
      if (NBK > 0) {
#pragma unroll
        for (int n = 0; n < NBK; ++n) *(f32x4*)(part + (wid * 32 + 16 * f + (lane & 15)) * 48 + 16 * n + 4 * (lane >> 4)) = acc[f][n];
      }
    }
    __syncthreads();
    if (tid < 32) {
      const float tot = (ssp[tid] + ssp[32 + tid]) + (ssp[64 + tid] + ssp[96 + tid]);
      const float rs = rsqrtf(tot * (1.f / D) + EPS);
      rstd_out[32 * it + tid] = rs;
      if (SMALL == 2) {
        float* lg = lgs + tid * 40;
        for (int c = 0; c < 36; ++c) {
          const float sacc = (part[(0 * 32 + tid) * 48 + c] + part[(1 * 32 + tid) * 48 + c]) + (part[(2 * 32 + tid) * 48 + c] + part[(3 * 32 + tid) * 48 + c]);
          lg[c] = rs * sacc + (c < 4 ? p.in[26][layer * 4 + c] : p.in[28][layer * 32 + (c - 4)]);
        }
        int grp = 0; float gm = lg[0];
#pragma unroll
        for (int c = 1; c < 4; ++c) if (lg[c] > gm) { gm = lg[c]; grp = c; }
        float gs = 0.f;
#pragma unroll
        for (int c = 0; c < 4; ++c) gs += __expf(lg[c] - gm);
        const float ptop = 1.f / gs;
        float el[8];
#pragma unroll
        for (int j = 0; j < 8; ++j) el[j] = lg[4 + grp * 8 + j];
        int i0 = 0; float m0 = el[0];
#pragma unroll
        for (int j = 1; j < 8; ++j) if (el[j] > m0) { m0 = el[j]; i0 = j; }
        int i1 = -1; float m1 = -3.0e38f;
#pragma unroll
        for (int j = 0; j < 8; ++j) if (j != i0 && el[j] > m1) { m1 = el[j]; i1 = j; }
        const float w0 = 1.f / (1.f + __expf(m1 - m0)), w1 = 1.f - w0;
        const int e0 = grp * 8 + i0, e1 = grp * 8 + i1;
        const int trow = 32 * it + tid;
        int* cnt = ctl + CT_CNT + layer * NE;
        const int r0 = atomicAdd(cnt + e0, 1), r1 = atomicAdd(cnt + e1, 1);
        int* list = (int*)(ws + WS_LIST); float* glist = (float*)(ws + WS_GLIST);
        list[e0 * NTOK + r0] = trow; glist[e0 * NTOK + r0] = ptop * w0;
        list[e1 * NTOK + r1] = trow; glist[e1 * NTOK + r1] = ptop * w1;
        toke[trow * 4 + 0] = e0; toke[trow * 4 + 1] = e1; toke[trow * 4 + 2] = r0; toke[trow * 4 + 3] = r1;
      }
    }
    if (SMALL == 1) {
      float* gates = (float*)(ws + WS_GATES);
      for (int q = tid; q < 32 * 24; q += NTHR) {
        const int r = q / 24, c = q % 24;
        const float tot = (ssp[r] + ssp[32 + r]) + (ssp[64 + r] + ssp[96 + r]);
        const float rs = rsqrtf(tot * (1.f / D) + EPS);
        const float sacc = (part[(0 * 32 + r) * 48 + c] + part[(1 * 32 + r) * 48 + c]) + (part[(2 * 32 + r) * 48 + c] + part[(3 * 32 + r) * 48 + c]);
        gates[(size_t)(32 * it + r) * 32 + c] = rs * sacc;
      }
    }
    __syncthreads();
  }
}

DEVI void final_combine(const Params& p, int vb, int G, char* lds) {
  unsigned char* ws = p.ws;
  const bf16* hbuf = (const bf16*)(ws + WS_H);
  const bf16* ymoe = (const bf16*)(ws + WS_YMOE);
  const int* toke = (const int*)(ws + WS_TOKE);
  int* ioff = (int*)lds; int* itp = ioff + 40; int* icnt = itp + 40;
  moe_offsets((const int*)(ws + WS_CTL) + CT_CNT + NE, ioff, itp, icnt);
  const int lane = threadIdx.x & 63, wid = threadIdx.x >> 6;
  for (int r = vb * 4 + wid; r < NB * SEQ; r += G * 4) {
    const int b = r / SEQ, s = r - b * SEQ, row = b * T + NMETA + s;
    const int e0 = toke[row * 4 + 0], e1 = toke[row * 4 + 1], r0 = toke[row * 4 + 2], r1 = toke[row * 4 + 3];
    const bf16* y0 = ymoe + (size_t)(ioff[e0] + r0) * D; const bf16* y1 = ymoe + (size_t)(ioff[e1] + r1) * D;
    const bf16* hs = hbuf + (size_t)row * D; float* o = p.out + (size_t)r * D;
#pragma unroll
    for (int j = 0; j < 4; ++j) {
      const int k = 8 * lane + 512 * j;
      const u32x4 hu = *(const u32x4*)(hs + k);
      f32x4 a, c; a[0] = bflo(hu.x); a[1] = bfhi(hu.x); a[2] = bflo(hu.y); a[3] = bfhi(hu.y); c[0] = bflo(hu.z); c[1] = bfhi(hu.z); c[2] = bflo(hu.w); c[3] = bfhi(hu.w);
      const u32x4 u0 = *(const u32x4*)(y0 + k), u1 = *(const u32x4*)(y1 + k);
      a[0] += bflo(u0.x) + bflo(u1.x); a[1] += bfhi(u0.x) + bfhi(u1.x); a[2] += bflo(u0.y) + bflo(u1.y); a[3] += bfhi(u0.y) + bfhi(u1.y);
      c[0] += bflo(u0.z) + bflo(u1.z); c[1] += bfhi(u0.z) + bfhi(u1.z); c[2] += bflo(u0.w) + bflo(u1.w); c[3] += bfhi(u0.w) + bfhi(u1.w);
      *(f32x4*)(o + k) = a; *(f32x4*)(o + k + 4) = c;
    }
  }
}

template <class Epi, int VAR = 0>
DEVI void gemm_tile(const bf16* __restrict__ A, int lda, const int* __restrict__ rows, int nvalid, int arow0,
                    const bf16* __restrict__ Bt, int ldb, int K, char* lds, const Epi& epi) {
  const int tid = threadIdx.x, lane = tid & 63, wid = tid >> 6, wm = wid >> 1, wn = wid & 1;
  const int srow = tid >> 3, sch = tid & 7;
  const bf16* ap[4]; const bf16* bp[4]; unsigned sw[4];
#pragma unroll
  for (int i = 0; i < 4; ++i) {
    const int r = srow + 32 * i;
    int gr;
    if (rows) { const int rr = r < nvalid ? r : 0; gr = rows[rr]; } else gr = arow0 + r;
    ap[i] = A + (size_t)gr * lda + sch * 8;
    bp[i] = Bt + (size_t)r * ldb + sch * 8;
    sw[i] = (unsigned)(r * 128 + ((sch ^ ((r >> 1) & 7)) << 4));
  }
  u32x4 ra0[4], rb0[4], ra1[4], rb1[4];
  f32x4 acc[4][4];
#pragma unroll
  for (int i = 0; i < 4; ++i)
#pragma unroll
    for (int j = 0; j < 4; ++j) acc[i][j] = (f32x4){0.f, 0.f, 0.f, 0.f};
  const int arl = wm * 64 + (lane & 15), brl = wn * 64 + (lane & 15);
  const int swa = (arl >> 1) & 7, swb = (brl >> 1) & 7;
  const int nk = K >> 6;
#define G_LOAD(RA, RB, kt_) do { if (VAR != 3 && VAR < 5) { _Pragma("unroll") for (int i = 0; i < 4; ++i) { RA[i] = *(const u32x4*)(ap[i] + (kt_) * 64); RB[i] = *(const u32x4*)(bp[i] + (kt_) * 64); } } } while (0)
#define G_STORE(RA, RB, buf_) do { if (VAR == 7) break; char* nb_ = lds + (buf_) * 32768; _Pragma("unroll") for (int i = 0; i < 4; ++i) { *(u32x4*)(nb_ + sw[i]) = RA[i]; *(u32x4*)(nb_ + 16384 + sw[i]) = RB[i]; } } while (0)
#define G_COMPUTE(buf_) do { if (VAR == 2) break; const char* base = lds + (buf_) * 32768; \
    bf16x8 af[2][4], bfr[2][4]; \
    _Pragma("unroll") for (int kk = 0; kk < 2; ++kk) { const int c = 4 * kk + (lane >> 4); \
      if (VAR >= 6) { _Pragma("unroll") for (int i = 0; i < 4; ++i) { af[kk][i] = u4_as_b8(ra0[i]); bfr[kk][i] = u4_as_b8(rb1[i]); asm volatile("" : "+v"(af[kk][i]), "+v"(bfr[kk][i])); } } else { \
      _Pragma("unroll") for (int i = 0; i < 4; ++i) af[kk][i] = *(const bf16x8*)(base + (arl + 16 * i) * 128 + ((c ^ swa) << 4)); \
      _Pragma("unroll") for (int j = 0; j < 4; ++j) bfr[kk][j] = *(const bf16x8*)(base + 16384 + (brl + 16 * j) * 128 + ((c ^ swb) << 4)); } } \
    _Pragma("unroll") for (int kk = 0; kk < 2; ++kk) { \
      if (VAR == 1 || VAR == 5) { _Pragma("unroll") for (int i = 0; i < 4; ++i) { asm volatile("" :: "v"(af[kk][i]), "v"(bfr[kk][i])); } } \
      else { _Pragma("unroll") for (int i = 0; i < 4; ++i) _Pragma("unroll") for (int j = 0; j < 4; ++j) acc[i][j] = mfma16(bfr[kk][j], af[kk][i], acc[i][j]); } } } while (0)
  if (VAR == 3 || VAR >= 5) { _Pragma("unroll") for (int i = 0; i < 4; ++i) { ra0[i] = (u32x4){1u,2u,3u,4u}; rb0[i] = ra0[i]; ra1[i] = ra0[i]; rb1[i] = ra0[i]; } }
  G_LOAD(ra0, rb0, 0);
  G_LOAD(ra1, rb1, 1);
  G_STORE(ra0, rb0, 0);
  if (VAR != 4) __syncthreads();
  for (int kt = 0; kt < nk; kt += 2) {
    const int k2 = kt + 2 < nk ? kt + 2 : nk - 1, k3 = kt + 3 < nk ? kt + 3 : nk - 1;
    G_LOAD(ra0, rb0, k2);
    __builtin_amdgcn_sched_barrier(0);
    G_COMPUTE(0);
    G_STORE(ra1, rb1, 1);
    if (VAR != 4) __syncthreads();
    G_LOAD(ra1, rb1, k3);
    __builtin_amdgcn_sched_barrier(0);
    G_COMPUTE(1);
    G_STORE(ra0, rb0, 0);
    if (VAR != 4) __syncthreads();
  }
#undef G_LOAD
#undef G_STORE
#undef G_COMPUTE
  epi(acc, wm, wn, lane);
}

DEVI void tile_of(int L, int MT, int NT, int& pm, int& pn) {
  const int nig = 8 * NT, gid = L / nig, fm = gid * 8, gsz = (MT - fm) < 8 ? (MT - fm) : 8;
  const int w = L - gid * nig;
  pm = fm + (w % gsz); pn = w / gsz;
}

struct TileDesc { const bf16* A; int lda; const int* rows; int nvalid; int arow0; const bf16* Bt; int ldb; int K; };
template <class Src>
DEVI void gemm_loop(const Src& src, int first, int stride, int count, char* lds) {
  if (first >= count) return;
  const int tid = threadIdx.x, lane = tid & 63, wid = tid >> 6, wm = wid >> 1, wn = wid & 1;
  const int srow = tid >> 3, sch = (tid & 7) ^ ((tid >> 4) & 7);
  const int arl = wm * 64 + (lane & 15), brl = wn * 64 + (lane & 15);
  const int swa = (arl >> 1) & 7, swb = (brl >> 1) & 7;
  const bf16* ap[4]; const bf16* bp[4]; const bf16* apn[4]; const bf16* bpn[4];
#define GL_SETUP(AP, BP, d_) do { _Pragma("unroll") for (int i = 0; i < 4; ++i) { const int r = srow + 32 * i; int gr; \
      if ((d_).rows) { const int rr = r < (d_).nvalid ? r : 0; gr = (d_).rows[rr]; } else gr = (d_).arow0 + r; \
      AP[i] = (d_).A + (size_t)gr * (d_).lda + sch * 8; BP[i] = (d_).Bt + (size_t)r * (d_).ldb + sch * 8; } } while (0)
#define GL_DMA(AP, BP, koff_, buf_) do { _Pragma("unroll") for (int i = 0; i < 4; ++i) { \
      __builtin_amdgcn_global_load_lds((const unsigned*)(AP[i] + (koff_)), (LAS unsigned*)(lds + (buf_) * 32768 + i * 4096 + wid * 1024), 16, 0, 0); \
      __builtin_amdgcn_global_load_lds((const unsigned*)(BP[i] + (koff_)), (LAS unsigned*)(lds + (buf_) * 32768 + 16384 + i * 4096 + wid * 1024), 16, 0, 0); } } while (0)
#define GL_COMPUTE(buf_) do { const char* base = lds + (buf_) * 32768; \
    _Pragma("unroll") for (int kk = 0; kk < 2; ++kk) { const int c = 4 * kk + (lane >> 4); bf16x8 af[4], bfr[4]; \
      _Pragma("unroll") for (int i = 0; i < 4; ++i) af[i] = *(const bf16x8*)(base + (arl + 16 * i) * 128 + ((c ^ swa) << 4)); \
      _Pragma("unroll") for (int j = 0; j < 4; ++j) bfr[j] = *(const bf16x8*)(base + 16384 + (brl + 16 * j) * 128 + ((c ^ swb) << 4)); \
      __builtin_amdgcn_s_setprio(1); \
      _Pragma("unroll") for (int i = 0; i < 4; ++i) _Pragma("unroll") for (int j = 0; j < 4; ++j) acc[i][j] = mfma16(bfr[j], af[i], acc[i][j]); \
      __builtin_amdgcn_s_setprio(0); } } while (0)
#define GL_WAITSYNC() do { asm volatile("s_waitcnt vmcnt(0)" ::: "memory"); __syncthreads(); } while (0)
  f32x4 acc[4][4];
  TileDesc d; src.tile(first, d);
  GL_SETUP(ap, bp, d);
  int nk = d.K >> 6;
  GL_DMA(ap, bp, 0, 0);
  GL_WAITSYNC();
  for (int idx = first; idx < count; idx += stride) {
    const int nidx = idx + stride < count ? idx + stride : idx;
    TileDesc dn; src.tile(nidx, dn);
    GL_SETUP(apn, bpn, dn);
#pragma unroll
    for (int i = 0; i < 4; ++i)
#pragma unroll
      for (int j = 0; j < 4; ++j) acc[i][j] = (f32x4){0.f, 0.f, 0.f, 0.f};
#pragma unroll 1
    for (int kt = 0; kt < nk; kt += 2) {
      GL_DMA(ap, bp, (kt + 1) * 64, 1);
      GL_COMPUTE(0);
      GL_WAITSYNC();
      {
        const bool last = kt + 2 >= nk;
        const bf16* pa[4]; const bf16* pb[4];
#pragma unroll
        for (int i = 0; i < 4; ++i) { pa[i] = last ? apn[i] : ap[i] + (kt + 2) * 64; pb[i] = last ? bpn[i] : bp[i] + (kt + 2) * 64; }
        GL_DMA(pa, pb, 0, 0);
      }
      GL_COMPUTE(1);
      GL_WAITSYNC();
    }
    src.epilogue(idx, acc, wm, wn, lane);
#pragma unroll
    for (int i = 0; i < 4; ++i) { ap[i] = apn[i]; bp[i] = bpn[i]; }
    nk = dn.K >> 6;
  }
#undef GL_SETUP
#undef GL_DMA
#undef GL_COMPUTE
#undef GL_WAITSYNC
}

template <class Src>
DEVI void gemm_loop_half(const Src& src, int first, int stride, int count, char* lds) {
  if (first >= count) return;
  const int tid = threadIdx.x, lane = tid & 63, wid = tid >> 6;
  const int srow = tid >> 3, sch = (tid & 7) ^ ((tid >> 4) & 7);
  const int arl = wid * 32 + (lane & 15), brl = (lane & 15);
  const int swa = (arl >> 1) & 7, swb = (brl >> 1) & 7;
  const bf16* ap[4]; const bf16* bp[2]; const bf16* apn[4]; const bf16* bpn[2];
#define GH_SETUP(AP, BP, d_) do { _Pragma("unroll") for (int i = 0; i < 4; ++i) { const int r = srow + 32 * i; int gr; \
      if ((d_).rows) { const int rr = r < (d_).nvalid ? r : 0; gr = (d_).rows[rr]; } else gr = (d_).arow0 + r; \
      AP[i] = (d_).A + (size_t)gr * (d_).lda + sch * 8; if (i < 2) BP[i] = (d_).Bt + (size_t)r * (d_).ldb + sch * 8; } } while (0)
#define GH_DMA(AP, BP, koff_, buf_) do { _Pragma("unroll") for (int i = 0; i < 4; ++i) { \
      __builtin_amdgcn_global_load_lds((const unsigned*)(AP[i] + (koff_)), (LAS unsigned*)(lds + (buf_) * 32768 + i * 4096 + wid * 1024), 16, 0, 0); \
      if (i < 2) __builtin_amdgcn_global_load_lds((const unsigned*)(BP[i] + (koff_)), (LAS unsigned*)(lds + (buf_) * 32768 + 16384 + i * 4096 + wid * 1024), 16, 0, 0); } } while (0)
#define GH_COMPUTE(buf_) do { const char* base = lds + (buf_) * 32768; \
    _Pragma("unroll") for (int kk = 0; kk < 2; ++kk) { const int c = 4 * kk + (lane >> 4); bf16x8 af[2], bfr[4]; \
      _Pragma("unroll") for (int i = 0; i < 2; ++i) af[i] = *(const bf16x8*)(base + (arl + 16 * i) * 128 + ((c ^ swa) << 4)); \
      _Pragma("unroll") for (int j = 0; j < 4; ++j) bfr[j] = *(const bf16x8*)(base + 16384 + (brl + 16 * j) * 128 + ((c ^ swb) << 4)); \
      __builtin_amdgcn_s_setprio(1); \
      _Pragma("unroll") for (int i = 0; i < 2; ++i) _Pragma("unroll") for (int j = 0; j < 4; ++j) acc[i][j] = mfma16(bfr[j], af[i], acc[i][j]); \
      __builtin_amdgcn_s_setprio(0); } } while (0)
#define GH_WAITSYNC() do { asm volatile("s_waitcnt vmcnt(0)" ::: "memory"); __syncthreads(); } while (0)
  f32x4 acc[2][4];
  TileDesc d; src.tile(first, d);
  GH_SETUP(ap, bp, d);
  int nk = d.K >> 6;
  GH_DMA(ap, bp, 0, 0);
  GH_WAITSYNC();
  for (int idx = first; idx < count; idx += stride) {
    const int nidx = idx + stride < count ? idx + stride : idx;
    TileDesc dn; src.tile(nidx, dn);
    GH_SETUP(apn, bpn, dn);
#pragma unroll
    for (int i = 0; i < 2; ++i)
#pragma unroll
      for (int j = 0; j < 4; ++j) acc[i][j] = (f32x4){0.f, 0.f, 0.f, 0.f};
#pragma unroll 1
    for (int kt = 0; kt < nk; kt += 2) {
      GH_DMA(ap, bp, (kt + 1) * 64, 1);
      GH_COMPUTE(0);
      GH_WAITSYNC();
      {
        const bool last = kt + 2 >= nk;
        const bf16* pa[4]; const bf16* pb[2];
#pragma unroll
        for (int i = 0; i < 4; ++i) { pa[i] = last ? apn[i] : ap[i] + (kt + 2) * 64; if (i < 2) pb[i] = last ? bpn[i] : bp[i] + (kt + 2) * 64; }
        GH_DMA(pa, pb, 0, 0);
      }
      GH_COMPUTE(1);
      GH_WAITSYNC();
    }
    src.epilogue_half(idx, acc, wid, lane);
#pragma unroll
    for (int i = 0; i < 4; ++i) { ap[i] = apn[i]; if (i < 2) bp[i] = bpn[i]; }
    nk = dn.K >> 6;
  }
#undef GH_SETUP
#undef GH_DMA
#undef GH_COMPUTE
#undef GH_WAITSYNC
}

struct EpiBf16 {
  bf16* out; int ldo; const float* rs; int m0, n0, mvalid;
  DEVI void operator()(const f32x4 (&acc)[4][4], int wm, int wn, int lane) const {
#pragma unroll
    for (int i = 0; i < 4; ++i) {
      const int row = m0 + wm * 64 + 16 * i + (lane & 15);
      if (row < mvalid) {
        const float s = rs ? rs[row] : 1.f;
#pragma unroll
        for (int j = 0; j < 4; ++j) {
          const int col = n0 + wn * 64 + 16 * j + 4 * (lane >> 4);
          u32x2 o; o.x = pk2(acc[i][j][0] * s, acc[i][j][1] * s); o.y = pk2(acc[i][j][2] * s, acc[i][j][3] * s);
          *(u32x2*)(out + (size_t)row * ldo + col) = o;
        }
      }
    }
  }
};
struct EpiResid {
  bf16* h; int m0, n0;
  DEVI void operator()(const f32x4 (&acc)[4][4], int wm, int wn, int lane) const {
#pragma unroll
    for (int i = 0; i < 4; ++i) {
      const int row = m0 + wm * 64 + 16 * i + (lane & 15);
      if (row < NTOK) {
#pragma unroll
        for (int j = 0; j < 4; ++j) {
          bf16* d = h + (size_t)row * D + n0 + wn * 64 + 16 * j + 4 * (lane >> 4);
          const u32x2 hu = *(const u32x2*)d;
          u32x2 o; o.x = pk2(bflo(hu.x) + acc[i][j][0], bfhi(hu.x) + acc[i][j][1]); o.y = pk2(bflo(hu.y) + acc[i][j][2], bfhi(hu.y) + acc[i][j][3]);
          *(u32x2*)d = o;
        }
      }
    }
  }
};
struct EpiResidAtomic {
  float* h; int m0, n0;
  DEVI void operator()(const f32x4 (&acc)[4][4], int wm, int wn, int lane) const {
#pragma unroll
    for (int i = 0; i < 4; ++i) {
      const int row = m0 + wm * 64 + 16 * i + (lane & 15);
      if (row < NTOK) {
#pragma unroll
        for (int j = 0; j < 4; ++j) {
          const int col = n0 + wn * 64 + 16 * j + 4 * (lane >> 4);
          float* d = h + (size_t)row * D + col;
#pragma unroll
          for (int r = 0; r < 4; ++r) __hip_atomic_fetch_add(d + r, acc[i][j][r], __ATOMIC_RELAXED, __HIP_MEMORY_SCOPE_AGENT);
        }
      }
    }
  }
};
struct EpiSplitZ {
  float* zt; int n0; int ld;
  DEVI void operator()(const f32x4 (&acc)[4][4], int wm, int wn, int lane) const {
    if (wm == 0) {
#pragma unroll
      for (int i = 0; i < 4; ++i) {
        const int rl = 16 * i + (lane & 15);
#pragma unroll
        for (int j = 0; j < 4; ++j) *(f32x4*)(zt + (size_t)rl * ld + n0 + wn * 64 + 16 * j + 4 * (lane >> 4)) = acc[i][j];
      }
    }
  }
};
struct EpiMoe1 {
  bf16* hb; const int* rows; const float* rs; int cnt, slot0, c0;
  DEVI void operator()(const f32x4 (&acc)[4][4], int wm, int wn, int lane) const {
#pragma unroll
    for (int i = 0; i < 4; ++i) {
      const int rl = wm * 64 + 16 * i + (lane & 15);
      if (rl < cnt) {
        const float s = rs[rows[rl]];
#pragma unroll
        for (int jj = 0; jj < 2; ++jj) {
          const int col = c0 + wn * 32 + 16 * jj + 4 * (lane >> 4);
          float v[4];
#pragma unroll
          for (int r = 0; r < 4; ++r) { const float a = acc[i][2 * jj][r] * s, b = acc[i][2 * jj + 1][r] * s; v[r] = siluf_(a) * b; }
          u32x2 o; o.x = pk2(v[0], v[1]); o.y = pk2(v[2], v[3]);
          *(u32x2*)(hb + (size_t)(slot0 + rl) * 512 + col) = o;
        }
      }
    }
  }
};
struct EpiMoe2 {
  bf16* y; const float* gl; int cnt, slot0, n0;
  DEVI void operator()(const f32x4 (&acc)[4][4], int wm, int wn, int lane) const {
#pragma unroll
    for (int i = 0; i < 4; ++i) {
      const int rl = wm * 64 + 16 * i + (lane & 15);
      if (rl < cnt) {
        const float s = gl[rl];
#pragma unroll
        for (int j = 0; j < 4; ++j) {
          const int col = n0 + wn * 64 + 16 * j + 4 * (lane >> 4);
          u32x2 o; o.x = pk2(acc[i][j][0] * s, acc[i][j][1] * s); o.y = pk2(acc[i][j][2] * s, acc[i][j][3] * s);
          *(u32x2*)(y + (size_t)(slot0 + rl) * D + col) = o;
        }
      }
    }
  }
};

template <class MakeEpi>
struct DenseSrc {
  const bf16* A; int lda; const bf16* Bt; int K, MT, NT; const MakeEpi& mk;
  DEVI void tile(int L, TileDesc& d) const { int pm, pn; tile_of(L, MT, NT, pm, pn); d.A = A; d.lda = lda; d.rows = nullptr; d.nvalid = 128; d.arow0 = pm * 128; d.Bt = Bt + (size_t)pn * 128 * K; d.ldb = K; d.K = K; }
  DEVI void epilogue(int L, const f32x4 (&acc)[4][4], int wm, int wn, int lane) const { int pm, pn; tile_of(L, MT, NT, pm, pn); auto e = mk(pm * 128, pn * 128); e(acc, wm, wn, lane); }
};
template <class MakeEpi>
DEVI void gemm_phase(const bf16* A, int lda, const bf16* Bt, int K, int N, int vb, int G, char* lds, const MakeEpi& mk, int flags = 0) {
  DenseSrc<MakeEpi> src{A, lda, Bt, K, MPAD / 128, N / 128, mk};
  gemm_loop(src, vb, G, (MPAD / 128) * (N / 128), lds);
}
DEVI void outproj_phase(const bf16* A, const bf16* Bt, bf16* h, unsigned char* ws, int layer, int vb, int G, char* lds) {
  {
    auto mk = [&](int m0, int n0) { return EpiResid{h, m0, n0}; };
    DenseSrc<decltype(mk)> src{A, D, Bt, 2048, 64, 16, mk};
    gemm_loop(src, vb, G, 64 * 16, lds);
  }
  {
    float* slabs = (float*)(ws + WS_ZT);
    int* tickets = (int*)(ws + WS_CTL) + CT_SPLITZ + 64 + layer * 16;
    int* flag = (int*)(lds + 65536);
    for (int it = vb; it < 128; it += G) {
      const int pn = it >> 3, ks = it & 7;
      EpiSplitZ epi{slabs + (size_t)ks * 64 * 2048, pn * 128, 2048};
      gemm_tile(A + ks * 256, D, nullptr, 128, 64 * 128, Bt + (size_t)pn * 128 * 2048 + ks * 256, 2048, 256, lds, epi);
      asm volatile("s_waitcnt vmcnt(0)" ::: "memory");
      __syncthreads();
      if (threadIdx.x == 0) {
        __builtin_amdgcn_fence(__ATOMIC_RELEASE, "agent");
        asm volatile("s_waitcnt vmcnt(0)" ::: "memory");
        const int t = __hip_atomic_fetch_add(tickets + pn, 1, __ATOMIC_RELAXED, __HIP_MEMORY_SCOPE_AGENT);
        if (t == 7) { __builtin_amdgcn_fence(__ATOMIC_ACQUIRE, "agent"); asm volatile("s_waitcnt vmcnt(0)" ::: "memory"); }
        *flag = (t == 7);
      }
      __syncthreads();
      if (*flag) {
        const int tid = threadIdx.x;
#pragma unroll
        for (int i = 0; i < 8; ++i) {
          const int idx = tid + 256 * i, rl = idx >> 5, c4 = (idx & 31) * 4;
          f32x4 v = *(const f32x4*)(slabs + (size_t)rl * 2048 + pn * 128 + c4);
#pragma unroll
          for (int q = 1; q < 8; ++q) v += *(const f32x4*)(slabs + (size_t)q * 64 * 2048 + (size_t)rl * 2048 + pn * 128 + c4);
          bf16* d = h + (size_t)(8192 + rl) * D + pn * 128 + c4;
          const u32x2 hu = *(const u32x2*)d;
          u32x2 o; o.x = pk2(bflo(hu.x) + v[0], bfhi(hu.x) + v[1]); o.y = pk2(bflo(hu.y) + v[2], bfhi(hu.y) + v[3]);
          *(u32x2*)d = o;
        }
      }
      __syncthreads();
    }
  }
}

DEVI void inproj0_phase(const Params& p, int vb, int G, char* lds) {
  unsigned char* ws = p.ws;
  const bf16* A = (const bf16*)(ws + WS_XN); const bf16* Bt = (const bf16*)(ws + WS_WIN0);
  bf16* Z = (bf16*)(ws + WS_Z); const float* rstd = (const float*)(ws + WS_RSTD);
  float* zt = (float*)(ws + WS_ZT);
  int* tickets = (int*)(ws + WS_CTL) + CT_SPLITZ;
  {
    auto mk = [&](int m0, int n0) { return EpiBf16{Z, ZLD0, rstd, m0, n0, NTOK}; };
    DenseSrc<decltype(mk)> src{A, D, Bt, 2048, 64, 48, mk};
    gemm_loop(src, vb, G, 64 * 48, lds);
  }
  int* flag = (int*)(lds + 65536);
  for (int it = vb; it < 48 * 8; it += G) {
    const int pn = it >> 3, ks = it & 7;
    EpiSplitZ epi{zt + (size_t)ks * 64 * 6144, pn * 128, 6144};
    gemm_tile(A + ks * 256, D, nullptr, 128, 64 * 128, Bt + (size_t)pn * 128 * 2048 + ks * 256, 2048, 256, lds, epi);
    asm volatile("s_waitcnt vmcnt(0)" ::: "memory");
    __syncthreads();
    if (threadIdx.x == 0) {
      __builtin_amdgcn_fence(__ATOMIC_RELEASE, "agent");
      asm volatile("s_waitcnt vmcnt(0)" ::: "memory");
      const int t = __hip_atomic_fetch_add(tickets + pn, 1, __ATOMIC_RELAXED, __HIP_MEMORY_SCOPE_AGENT);
      if (t == 7) { __builtin_amdgcn_fence(__ATOMIC_ACQUIRE, "agent"); asm volatile("s_waitcnt vmcnt(0)" ::: "memory"); }
      *flag = (t == 7);
    }
    __syncthreads();
    if (*flag) {
      const int tid = threadIdx.x;
#pragma unroll
      for (int i = 0; i < 8; ++i) {
        const int idx = tid + 256 * i, rl = idx >> 5, c4 = (idx & 31) * 4;
        f32x4 v = *(const f32x4*)(zt + (size_t)rl * 6144 + pn * 128 + c4);
#pragma unroll
        for (int q = 1; q < 8; ++q) v += *(const f32x4*)(zt + (size_t)q * 64 * 6144 + (size_t)rl * 6144 + pn * 128 + c4);
        const float sc = rstd[8192 + rl];
        u32x2 o; o.x = pk2(v[0] * sc, v[1] * sc); o.y = pk2(v[2] * sc, v[3] * sc);
        *(u32x2*)(Z + (size_t)(8192 + rl) * ZLD0 + pn * 128 + c4) = o;
      }
    }
    __syncthreads();
  }
}

constexpr int SQ = 0, SK = 16384, SV = 32768, SPM = 43008, SCT = 51200, SSC = 72704;

DEVI int qoff(int row, int dk) { return row * 256 + ((((dk >> 3) ^ (row & 15))) << 4) + (dk & 7) * 2; }

DEVI void scan_S(const char* lds, int wid, int lane, bf16x8 (&aq)[4], f32x4 (&accS)[4]) {
  const int l15 = lane & 15, g = lane >> 4;
#pragma unroll
  for (int j = 0; j < 4; ++j) accS[j] = (f32x4){0.f, 0.f, 0.f, 0.f};
#pragma unroll
  for (int ks = 0; ks < 4; ++ks) {
    const int c = 4 * ks + g;
    aq[ks] = *(const bf16x8*)(lds + SQ + (16 * wid + l15) * 256 + ((c ^ l15) << 4));
#pragma unroll
    for (int j = 0; j < 4; ++j) {
      const bf16x8 bk = *(const bf16x8*)(lds + SK + (16 * j + l15) * 256 + ((c ^ l15) << 4));
      accS[j] = mfma16(bk, aq[ks], accS[j]);
    }
  }
}
DEVI void scan_PM_write(char* lds, int wid, int lane, int j, const float (&v)[4]) {
  const int t = 16 * wid + (lane & 15), g = lane >> 4;
  const int cidx = 2 * j + (g >> 1);
  u32x2 o; o.x = pk2(v[0], v[1]); o.y = pk2(v[2], v[3]);
  *(u32x2*)(lds + SPM + t * 128 + ((cidx ^ ((t >> 1) & 7)) << 4) + 8 * (g & 1)) = o;
}
DEVI bf16x8 scan_Vfrag(const char* lds, int lane, int ks, int j) {
  const int g = lane >> 4, q = (lane & 15) >> 2, pp = lane & 3;
  const char* a0 = lds + SV + (32 * ks + 8 * g + q) * 160 + (16 * j + 4 * pp) * 2;
  return cat4(lds_tr16(a0), lds_tr16(a0 + 4 * 160));
}
DEVI bf16x8 scan_KTfrag(const char* lds, int lane, int ks, int dkb) {
  const int g = lane >> 4, q = (lane & 15) >> 2, pp = lane & 3;
  const int r0 = 32 * ks + 8 * g + q, r1 = r0 + 4;
  const int ch = (dkb >> 3) + (pp >> 1);
  const char* a0 = lds + SK + r0 * 256 + ((ch ^ (r0 & 15)) << 4) + 8 * (pp & 1);
  const char* a1 = lds + SK + r1 * 256 + ((ch ^ (r1 & 15)) << 4) + 8 * (pp & 1);
  return cat4(lds_tr16(a0), lds_tr16(a1));
}
template <int NBV>
DEVI void scan_PV(const char* lds, int wid, int lane, f32x4 (&accO)[NBV]) {
  const int t = 16 * wid + (lane & 15), g = lane >> 4;
#pragma unroll
  for (int ks = 0; ks < 2; ++ks) {
    const bf16x8 ap = *(const bf16x8*)(lds + SPM + t * 128 + (((4 * ks + g) ^ ((t >> 1) & 7)) << 4));
#pragma unroll
    for (int j = 0; j < NBV; ++j) accO[j] = mfma16(scan_Vfrag(lds, lane, ks, j), ap, accO[j]);
  }
}
template <int NBV>
DEVI void scan_QC(const char* lds, int lane, const bf16x8 (&aq)[4], f32x4 (&accO)[NBV]) {
  const int g = lane >> 4, q = (lane & 15) >> 2, pp = lane & 3;
#pragma unroll
  for (int ks = 0; ks < 4; ++ks) {
    const char* r0 = lds + SCT + (32 * ks + 8 * g + q) * 168 + 8 * pp;
#pragma unroll
    for (int j = 0; j < NBV; ++j) {
      const bf16x8 bc = cat4(lds_tr16(r0 + 32 * j), lds_tr16(r0 + 4 * 168 + 32 * j));
      accO[j] = mfma16(bc, aq[ks], accO[j]);
    }
  }
}
template <int NBV>
DEVI void scan_CT_write(char* lds, int wid, int lane, const f32x4 (&st)[2][NBV], float sc0, float sc1) {
  const int g = lane >> 4;
#pragma unroll
  for (int i = 0; i < 2; ++i) {
    const int dk = 32 * wid + 16 * i + (lane & 15);
    const float sc = i ? sc1 : sc0;
#pragma unroll
    for (int j = 0; j < NBV; ++j) {
      u32x2 o; o.x = pk2(st[i][j][0] * sc, st[i][j][1] * sc); o.y = pk2(st[i][j][2] * sc, st[i][j][3] * sc);
      *(u32x2*)(lds + SCT + dk * 168 + (16 * j + 4 * g) * 2) = o;
    }
  }
}

DEVI void prep_copy_out(const char* lds, unsigned char* dstimg) {
  __syncthreads();
  const int tid = threadIdx.x;
#pragma unroll
  for (int i = 0; i < 8; ++i) *(u32x4*)(dstimg + (size_t)(tid + 256 * i) * 16) = *(const u32x4*)(lds + (tid + 256 * i) * 16);
  __syncthreads();
}
DEVI void mlstm_prep(const Params& p, int item, char* lds) {
  unsigned char* ws = p.ws;
  const bf16* Z = (const bf16*)(ws + WS_Z);
  const int tid = threadIdx.x;
  const int c = item % 33, bh = item / 33, b = bh >> 2, h = bh & 3;
  const int L = c == 0 ? 16 : 64, t0 = c == 0 ? 0 : 16 + 64 * (c - 1), HL = L >> 1;
  const int row0 = b * T + t0;
  const int dk = tid & 127, hh = tid >> 7;
  const int cq = h * 128 + dk, ck = 512 + cq;
  float wq[4], wk[4];
#pragma unroll
  for (int j = 0; j < 4; ++j) { wq[j] = p.in[4][j * 1024 + cq]; wk[j] = p.in[4][j * 1024 + ck]; }
  const float bq = p.in[5][cq], bk = p.in[5][ck];
  const int ts = hh * HL;
  float xq[35], xk[35];
  {
    const int rbase = row0 + ts - 3, rmin = b * T;
#pragma unroll
    for (int i = 0; i < 35; ++i) {
      int r = rbase + i; r = r < rmin ? rmin : r;
      const bf16* zr = Z + (size_t)r * ZLD0;
      xq[i] = bf2f(zr[cq]); xk[i] = bf2f(zr[ck]);
    }
    const int tl0 = t0 + ts - 3;
#pragma unroll
    for (int i = 0; i < 3; ++i) if (tl0 + i < 0) { xq[i] = 0.f; xk[i] = 0.f; }
  }
#pragma unroll
  for (int i = 0; i < 32; ++i) {
    if (i < HL) {
      const int t = ts + i;
      const float aq_ = bq + wq[0] * xq[i] + wq[1] * xq[i + 1] + wq[2] * xq[i + 2] + wq[3] * xq[i + 3];
      const float ak_ = bk + wk[0] * xk[i] + wk[1] * xk[i + 1] + wk[2] * xk[i + 2] + wk[3] * xk[i + 3];
      *(bf16*)(lds + SQ + qoff(t, dk)) = (bf16)f2bf(siluf_(aq_));
      *(bf16*)(lds + SK + qoff(t, dk)) = (bf16)f2bf(siluf_(ak_) * 0.08838834764831845f);
    }
  }
  if (L < 64) {
    const int rem = (64 - L) >> 1;
    for (int i = 0; i < rem; ++i) { const int t = L + hh * rem + i; *(bf16*)(lds + SQ + qoff(t, dk)) = 0; *(bf16*)(lds + SK + qoff(t, dk)) = 0; }
  }
  prep_copy_out(lds, ws + WS_PQK + (size_t)item * 32768);
}
template <bool HG>
DEVI void gla_prep(const Params& p, int item, char* lds) {
  unsigned char* ws = p.ws;
  const bf16* Z = (const bf16*)(ws + WS_Z);
  const float* gates = (const float*)(ws + WS_GATES);
  constexpr int ZLD = HG ? ZLD1 : ZLD0;
  const int tid = threadIdx.x;
  const int c = item % 33, bh = item / 33;
  const int b = HG ? (bh >> 3) : (bh >> 2), h = HG ? (bh & 7) : (bh & 3);
  const int L = c == 0 ? 16 : 64, t0 = c == 0 ? 0 : 16 + 64 * (c - 1), HL = L >> 1;
  const int row0 = b * T + t0;
  float* sc = (float*)(lds + SSC);
  float* TOT0 = sc; float* TOT1 = sc + 128; float* FIRST1 = sc + 256; float* BA = sc + 768;
  const int dk = tid & 127, hh = tid >> 7;
  const int ch = h * 128 + dk;
  const int qcol = HG ? ch : 3072 + ch, kcol = HG ? 1024 + ch : 3584 + ch;
  float wg[16]; float bg = 0.f, lb = 0.f;
  if (!HG) {
#pragma unroll
    for (int r = 0; r < 16; ++r) wg[r] = p.in[9][r * 512 + ch];
    bg = p.in[10][ch];
  } else {
    lb = 1.f / (1.f + __expf(p.in[15][ch] - p.in[15][1024 + ch]));
  }
  if (!HG) {
    const int s = tid >> 2, part = tid & 3;
    f32x4 v = (f32x4){0.f, 0.f, 0.f, 0.f};
    if (s < L) v = *(const f32x4*)(gates + (size_t)(row0 + s) * 32 + 8 + 4 * part);
    *(f32x4*)(BA + s * 16 + 4 * part) = v;
    __syncthreads();
  }
  const int ts = hh * HL;
  float kx[32], qx[32];
#pragma unroll
  for (int i = 0; i < 32; ++i) {
    const bf16* zr = Z + (size_t)(row0 + ts + i) * ZLD;
    kx[i] = bf2f(zr[kcol]); qx[i] = bf2f(zr[qcol]);
  }
  {
    float run = 0.f, first = 0.f;
#pragma unroll
    for (int i = 0; i < 32; ++i) {
      if (i < HL) {
        const int t = ts + i;
        float lg;
        if (!HG) {
          float a = bg;
#pragma unroll
          for (int r = 0; r < 4; ++r) { const f32x4 bb = *(const f32x4*)(BA + t * 16 + 4 * r); a += bb[0] * wg[4 * r] + bb[1] * wg[4 * r + 1] + bb[2] * wg[4 * r + 2] + bb[3] * wg[4 * r + 3]; }
          lg = logsigmoidf_(a) * (1.f / 16.f);
        } else {
          lg = __logf(lb + (1.f - lb) * sigmoidf_(kx[i]));
        }
        if (i == 0) first = lg;
        run += lg;
      }
    }
    if (hh == 0) TOT0[dk] = run; else { TOT1[dk] = run; FIRST1[dk] = first; }
  }
  __syncthreads();
  {
    const float tot0 = TOT0[dk], gref = tot0 + FIRST1[dk], gend = tot0 + TOT1[dk];
    float run = hh ? tot0 : 0.f;
#pragma unroll
    for (int i = 0; i < 32; ++i) {
      if (i < HL) {
        const int t = ts + i;
        float lg, kk;
        if (!HG) {
          float a = bg;
#pragma unroll
          for (int r = 0; r < 4; ++r) { const f32x4 bb = *(const f32x4*)(BA + t * 16 + 4 * r); a += bb[0] * wg[4 * r] + bb[1] * wg[4 * r + 1] + bb[2] * wg[4 * r + 2] + bb[3] * wg[4 * r + 3]; }
          lg = logsigmoidf_(a) * (1.f / 16.f);
          kk = kx[i];
        } else {
          const float sg = sigmoidf_(kx[i]);
          lg = __logf(lb + (1.f - lb) * sg);
          kk = (1.f - lb) * (1.f - sg);
        }
        run += lg;
        float q = qx[i];
        if (!HG) q *= 0.08838834764831845f;
        *(bf16*)(lds + SQ + qoff(t, dk)) = (bf16)f2bf(q * __expf(run - gref));
        *(bf16*)(lds + SK + qoff(t, dk)) = (bf16)f2bf(kk * __expf(gref - run));
      }
    }
    if (L < 64) {
      const int rem = (64 - L) >> 1;
      for (int i = 0; i < rem; ++i) { const int t = L + hh * rem + i; *(bf16*)(lds + SQ + qoff(t, dk)) = 0; *(bf16*)(lds + SK + qoff(t, dk)) = 0; }
    }
    const int img = HG ? item : 528 + item;
    if (hh == 0) {
      float* vec = (float*)(ws + WS_PVEC) + (size_t)img * 384;
      vec[dk] = __expf(gref); vec[128 + dk] = __expf(gend - gref); vec[256 + dk] = __expf(gend);
    }
    prep_copy_out(lds, ws + WS_PQK + (size_t)img * 32768);
  }
}

struct ScanPre { u32x4 q[4], k[4], v[2]; };
DEVI void scan_prefetch(ScanPre& pr, const unsigned char* img, const bf16* vsrc  , int zld, int L, int tid) {
#pragma unroll
  for (int i = 0; i < 4; ++i) { pr.q[i] = *(const u32x4*)(img + (size_t)(tid + 256 * i) * 16); pr.k[i] = *(const u32x4*)(img + 16384 + (size_t)(tid + 256 * i) * 16); }
  const int s = tid >> 2, part = tid & 3;
  const int sl = s < L ? s : 0;
  const bf16* src = vsrc + (size_t)sl * zld + 16 * part;
  pr.v[0] = *(const u32x4*)src; pr.v[1] = *(const u32x4*)(src + 8);
  if (s >= L) { pr.v[0] = (u32x4){0u, 0u, 0u, 0u}; pr.v[1] = pr.v[0]; }
}
DEVI void scan_store(const ScanPre& pr, char* lds, int tid) {
#pragma unroll
  for (int i = 0; i < 4; ++i) { *(u32x4*)(lds + SQ + (tid + 256 * i) * 16) = pr.q[i]; *(u32x4*)(lds + SK + (tid + 256 * i) * 16) = pr.k[i]; }
  const int s = tid >> 2, part = tid & 3;
  *(u32x4*)(lds + SV + s * 160 + 32 * part) = pr.v[0]; *(u32x4*)(lds + SV + s * 160 + 32 * part + 16) = pr.v[1];
}

DEVI void mlstm_item(const Params& p, int item, char* lds) {
  unsigned char* ws = p.ws;
  const bf16* Z = (const bf16*)(ws + WS_Z);
  const float* gates = (const float*)(ws + WS_GATES);
  bf16* hraw = (bf16*)(ws + WS_HRAW);
  const int tid = threadIdx.x, lane = tid & 63, wid = tid >> 6;
  const int b = item >> 4, h = (item >> 2) & 3, vs = item & 3;
  float* sc = (float*)(lds + SSC);
  float* Bc = sc; float* U = sc + 64; float* PMx = sc + 128; float* F = sc + 192; float* misc = sc + 256;
  const float b_i = p.in[6][h], b_f = p.in[7][h];
  const unsigned char* img0 = ws + WS_PQK + (size_t)((b * 4 + h) * 33) * 32768;
  const bf16* vbase = Z + (size_t)(b * T) * ZLD0 + 1024 + h * 256 + vs * 64;
  f32x4 st[2][5];
#pragma unroll
  for (int i = 0; i < 2; ++i)
#pragma unroll
    for (int j = 0; j < 5; ++j) st[i][j] = (f32x4){0.f, 0.f, 0.f, 0.f};
  float m = 0.f;
  ScanPre pr; float g_ai, g_af;
  scan_prefetch(pr, img0, vbase, ZLD0, 16, tid);
  { const int r = b * T + (lane < 16 ? lane : 0); g_ai = gates[(size_t)r * 32 + h]; g_af = gates[(size_t)r * 32 + 4 + h]; }
  for (int c = 0; c < 33; ++c) {
    const int L = c == 0 ? 16 : 64, t0 = c == 0 ? 0 : 16 + 64 * (c - 1);
    const int row0 = b * T + t0;
    scan_store(pr, lds, tid);
    {
      const int s = tid >> 2, part = tid & 3;
      if (part == 0) { u32x4 e0 = (u32x4){0u, 0u, 0u, 0u}; if (s < L) e0.x = 0x3F80u; *(u32x4*)(lds + SV + s * 160 + 128) = e0; *(u32x4*)(lds + SV + s * 160 + 144) = (u32x4){0u, 0u, 0u, 0u}; }
    }
    if (wid == 0) {
      const bool valid = lane < L;
      const float ig = valid ? g_ai + b_i : -1e30f, lf = valid ? logsigmoidf_(g_af + b_f) : 0.f;
      float bc = lf;
#pragma unroll
      for (int d = 1; d < 64; d <<= 1) { const float v = __shfl_up(bc, d); if (lane >= d) bc += v; }
      const float u = ig - bc;
      float pmx = u;
#pragma unroll
      for (int d = 1; d < 64; d <<= 1) { const float v = __shfl_up(pmx, d); if (lane >= d) pmx = fmaxf(pmx, v); }
      const float b_end = __shfl(bc, L - 1), umax = __shfl(pmx, L - 1);
      const float m_new = fmaxf(b_end + m, b_end + umax);
      Bc[lane] = bc; U[lane] = u; PMx[lane] = fmaxf(m, pmx);
      F[lane] = valid ? __expf(b_end + u - m_new) : 0.f;
      if (lane == 0) { misc[0] = m_new; misc[1] = __expf(b_end + m - m_new); }
    }
    __syncthreads();
    if (c + 1 < 33) {
      const int t1 = 16 + 64 * c;
      scan_prefetch(pr, img0 + (size_t)(c + 1) * 32768, vbase + (size_t)t1 * ZLD0, ZLD0, 64, tid);
      const int r = b * T + t1 + lane; g_ai = gates[(size_t)r * 32 + h]; g_af = gates[(size_t)r * 32 + 4 + h];
    }
    const float m_new = misc[0], a_st = misc[1];
    scan_CT_write<5>(lds, wid, lane, st, 1.f, 1.f);
    bf16x8 aq[4]; f32x4 accS[4];
    scan_S(lds, wid, lane, aq, accS);
    const int t = 16 * wid + (lane & 15), g = lane >> 4;
    const float pm_t = PMx[t];
#pragma unroll
    for (int j = 0; j < 4; ++j) {
      const f32x4 u4 = *(const f32x4*)(U + 16 * j + 4 * g);
      float v[4];
#pragma unroll
      for (int r = 0; r < 4; ++r) { const int s = 16 * j + 4 * g + r; v[r] = s <= t ? accS[j][r] * __expf(u4[r] - pm_t) : 0.f; }
      scan_PM_write(lds, wid, lane, j, v);
    }
    __syncthreads();
    {
      f32x4 o1[5], o2[5];
#pragma unroll
      for (int j = 0; j < 5; ++j) { o1[j] = (f32x4){0.f, 0.f, 0.f, 0.f}; o2[j] = o1[j]; }
      scan_PV<5>(lds, wid, lane, o1);
      scan_QC<5>(lds, lane, aq, o2);
      const float a_t = __expf(m - pm_t), m_t = Bc[t] + pm_t;
      const float den0 = o1[4][0] + a_t * o2[4][0];
      const float den = __shfl(den0, lane & 15);
      const float inv = 1.f / fmaxf(fabsf(den), __expf(-m_t));
      if (t < L) {
        bf16* dst = hraw + (size_t)(row0 + t) * D + h * 256 + vs * 64 + 4 * g;
#pragma unroll
        for (int j = 0; j < 4; ++j) {
          u32x2 o; o.x = pk2((o1[j][0] + a_t * o2[j][0]) * inv, (o1[j][1] + a_t * o2[j][1]) * inv); o.y = pk2((o1[j][2] + a_t * o2[j][2]) * inv, (o1[j][3] + a_t * o2[j][3]) * inv);
          *(u32x2*)(dst + 16 * j) = o;
        }
      }
    }
#pragma unroll
    for (int i = 0; i < 2; ++i)
#pragma unroll
      for (int j = 0; j < 5; ++j) st[i][j] *= a_st;
#pragma unroll
    for (int ks = 0; ks < 2; ++ks) {
      const f32x4 f0 = *(const f32x4*)(F + 32 * ks + 8 * g), f1 = *(const f32x4*)(F + 32 * ks + 8 * g + 4);
      bf16x8 ak[2];
#pragma unroll
      for (int i = 0; i < 2; ++i) {
        const bf16x8 kr = scan_KTfrag(lds, lane, ks, 32 * wid + 16 * i);
        bf16x8 o;
        o[0] = (short)f2bf(bf2f((bf16)kr[0]) * f0[0]); o[1] = (short)f2bf(bf2f((bf16)kr[1]) * f0[1]); o[2] = (short)f2bf(bf2f((bf16)kr[2]) * f0[2]); o[3] = (short)f2bf(bf2f((bf16)kr[3]) * f0[3]);
        o[4] = (short)f2bf(bf2f((bf16)kr[4]) * f1[0]); o[5] = (short)f2bf(bf2f((bf16)kr[5]) * f1[1]); o[6] = (short)f2bf(bf2f((bf16)kr[6]) * f1[2]); o[7] = (short)f2bf(bf2f((bf16)kr[7]) * f1[3]);
        ak[i] = o;
      }
#pragma unroll
      for (int j = 0; j < 5; ++j) {
        const bf16x8 bv = scan_Vfrag(lds, lane, ks, j);
#pragma unroll
        for (int i = 0; i < 2; ++i) st[i][j] = mfma16(bv, ak[i], st[i][j]);
      }
    }
    m = m_new;
    __syncthreads();
  }
}

template <bool HG>
DEVI void gla_item(const Params& p, int item, char* lds) {
  const int pf = p.flags >> 8;
  unsigned char* ws = p.ws;
  const bf16* Z = (const bf16*)(ws + WS_Z);
  bf16* hraw = (bf16*)(ws + WS_HRAW);
  constexpr int ZLD = HG ? ZLD1 : ZLD0;
  const int tid = threadIdx.x, lane = tid & 63, wid = tid >> 6;
  int b, h, vs;
  if (HG) { b = item >> 4; h = (item >> 1) & 7; vs = item & 1; } else { b = item >> 4; h = (item >> 2) & 3; vs = item & 3; }
  const int vcol = HG ? 2048 + h * 128 + vs * 64 : 4096 + h * 256 + vs * 64;
  const int ocol = HG ? h * 128 + vs * 64 : 1024 + h * 256 + vs * 64;
  const int img_base = HG ? (b * 8 + h) * 33 : 528 + (b * 4 + h) * 33;
  const unsigned char* img0 = ws + WS_PQK + (size_t)img_base * 32768;
  const float* vec0 = (const float*)(ws + WS_PVEC) + (size_t)img_base * 384;
  const bf16* vbase = Z + (size_t)(b * T) * ZLD + vcol;
  const int dk0 = 32 * wid + (lane & 15);
  f32x4 st[2][4];
#pragma unroll
  for (int i = 0; i < 2; ++i)
#pragma unroll
    for (int j = 0; j < 4; ++j) st[i][j] = (f32x4){0.f, 0.f, 0.f, 0.f};
  ScanPre pr; float vg[2], ve[2], vd[2];
  scan_prefetch(pr, img0, vbase, ZLD, 16, tid);
#pragma unroll
  for (int i = 0; i < 2; ++i) { vg[i] = vec0[dk0 + 16 * i]; ve[i] = vec0[128 + dk0 + 16 * i]; vd[i] = vec0[256 + dk0 + 16 * i]; }
  for (int c = 0; c < 33; ++c) {
    const int L = c == 0 ? 16 : 64, t0 = c == 0 ? 0 : 16 + 64 * (c - 1);
    const int row0 = b * T + t0;
    scan_store(pr, lds, tid);
    const float gr0 = vg[0], gr1 = vg[1], e20 = ve[0], e21 = ve[1], dc0 = vd[0], dc1 = vd[1];
    __syncthreads();
    if (c + 1 < 33) {
      const int t1 = 16 + 64 * c;
      scan_prefetch(pr, img0 + (size_t)(c + 1) * 32768, vbase + (size_t)t1 * ZLD, ZLD, 64, tid);
      const float* vec = vec0 + (size_t)(c + 1) * 384;
#pragma unroll
      for (int i = 0; i < 2; ++i) { vg[i] = vec[dk0 + 16 * i]; ve[i] = vec[128 + dk0 + 16 * i]; vd[i] = vec[256 + dk0 + 16 * i]; }
    }
    if (!(pf & 1)) scan_CT_write<4>(lds, wid, lane, st, gr0, gr1);
    bf16x8 aq[4]; f32x4 accS[4];
    scan_S(lds, wid, lane, aq, accS);
    const int t = 16 * wid + (lane & 15), g = lane >> 4;
#pragma unroll
    for (int j = 0; j < 4; ++j) {
      float v[4];
#pragma unroll
      for (int r = 0; r < 4; ++r) { const int s = 16 * j + 4 * g + r; v[r] = s <= t ? accS[j][r] : 0.f; }
      scan_PM_write(lds, wid, lane, j, v);
    }
    __syncthreads();
    {
      f32x4 o1[4];
#pragma unroll
      for (int j = 0; j < 4; ++j) o1[j] = (f32x4){0.f, 0.f, 0.f, 0.f};
      if (!(pf & 2)) { scan_PV<4>(lds, wid, lane, o1);
      scan_QC<4>(lds, lane, aq, o1); }
      if (t < L) {
        bf16* dst = hraw + (size_t)(row0 + t) * D + ocol + 4 * g;
#pragma unroll
        for (int j = 0; j < 4; ++j) { u32x2 o; o.x = pk2(o1[j][0], o1[j][1]); o.y = pk2(o1[j][2], o1[j][3]); *(u32x2*)(dst + 16 * j) = o; }
      }
    }
    {
      f32x4 fr[2][4];
#pragma unroll
      for (int i = 0; i < 2; ++i)
#pragma unroll
        for (int j = 0; j < 4; ++j) fr[i][j] = (f32x4){0.f, 0.f, 0.f, 0.f};
      if (!(pf & 4))
#pragma unroll
      for (int ks = 0; ks < 2; ++ks) {
        bf16x8 ak[2];
#pragma unroll
        for (int i = 0; i < 2; ++i) ak[i] = scan_KTfrag(lds, lane, ks, 32 * wid + 16 * i);
#pragma unroll
        for (int j = 0; j < 4; ++j) {
          const bf16x8 bv = scan_Vfrag(lds, lane, ks, j);
#pragma unroll
          for (int i = 0; i < 2; ++i) fr[i][j] = mfma16(bv, ak[i], fr[i][j]);
        }
      }
#pragma unroll
      for (int j = 0; j < 4; ++j) { st[0][j] = st[0][j] * dc0 + fr[0][j] * e20; st[1][j] = st[1][j] * dc1 + fr[1][j] * e21; }
    }
    __syncthreads();
  }
}

template <bool L1>
DEVI void yfin_rows(const Params& p, int rowfirst, int rowstride, int rowend) {
  unsigned char* ws = p.ws;
  const bf16* Z = (const bf16*)(ws + WS_Z);
  const bf16* hraw = (const bf16*)(ws + WS_HRAW);
  bf16* Y = (bf16*)(ws + WS_Y);
  const int lane = threadIdx.x & 63;
  constexpr int NJ = L1 ? 2 : 4;
  for (int row0 = rowfirst; row0 < rowend; row0 += 2 * rowstride) {
    u32x4 hv[2][NJ], gv[2][NJ];
#pragma unroll
    for (int q = 0; q < 2; ++q) {
      int row = row0 + q * rowstride; row = row < rowend ? row : rowfirst;
#pragma unroll
      for (int j = 0; j < NJ; ++j) {
        const int col = 8 * lane + 512 * j;
        hv[q][j] = *(const u32x4*)(hraw + (size_t)row * D + col);
        const bf16* gsrc;
        if (L1) gsrc = Z + (size_t)row * ZLD1 + 3072 + col;
        else if (col < 1024) gsrc = Z + (size_t)row * ZLD0 + 2048 + col;
        else gsrc = Z + (size_t)row * ZLD0 + 5120 + (col - 1024);
        gv[q][j] = *(const u32x4*)gsrc;
      }
    }
#pragma unroll
    for (int q = 0; q < 2; ++q) {
      const int row = row0 + q * rowstride;
      if (row < rowend) {
#pragma unroll
        for (int j = 0; j < NJ; ++j) {
          const int col = 8 * lane + 512 * j;
          const u32x4 h4 = hv[q][j], g4 = gv[q][j];
          float x[8] = {bflo(h4.x), bfhi(h4.x), bflo(h4.y), bfhi(h4.y), bflo(h4.z), bfhi(h4.z), bflo(h4.w), bfhi(h4.w)};
          float ss = 0.f;
#pragma unroll
          for (int e = 0; e < 8; ++e) ss += x[e] * x[e];
          ss += __shfl_xor(ss, 1); ss += __shfl_xor(ss, 2); ss += __shfl_xor(ss, 4); ss += __shfl_xor(ss, 8);
          if (!L1) ss += __shfl_xor(ss, 16);
          const float rs = rsqrtf(ss * (L1 ? 1.f / 128.f : 1.f / 256.f) + EPS);
          const bool silu_gate = !L1 && col >= 1024;
          const float* gn = L1 ? p.in[16] + col : (col < 1024 ? p.in[8] + col : p.in[11] + (col - 1024));
          const float gt[8] = {bflo(g4.x), bfhi(g4.x), bflo(g4.y), bfhi(g4.y), bflo(g4.z), bfhi(g4.z), bflo(g4.w), bfhi(g4.w)};
          const f32x4 n0 = *(const f32x4*)gn, n1 = *(const f32x4*)(gn + 4);
          const float nn[8] = {n0[0], n0[1], n0[2], n0[3], n1[0], n1[1], n1[2], n1[3]};
          float y[8];
#pragma unroll
          for (int e = 0; e < 8; ++e) { const float gg = silu_gate ? siluf_(gt[e]) : sigmoidf_(gt[e]); y[e] = gg * x[e] * rs * nn[e]; }
          u32x4 o; o.x = pk2(y[0], y[1]); o.y = pk2(y[2], y[3]); o.z = pk2(y[4], y[5]); o.w = pk2(y[6], y[7]);
          *(u32x4*)(Y + (size_t)row * D + col) = o;
        }
      }
    }
  }
}


constexpr float QSCALE = 0.10411755f;
DEVI void rope_cs(float pos, int i, float& c, float& s) {
  const float inv = exp2f(-0.41524101186092029f * (float)i);
  const float ang = pos * inv;
  const float n = rintf(ang * 0.15915494309189535f);
  const float r = (float)((double)ang - (double)n * 6.283185307179586);
  c = __cosf(r); s = __sinf(r);
}
DEVI void mla_row_stats(const Params& p, int vb, int G) {
  unsigned char* ws = p.ws;
  const bf16* Z = (const bf16*)(ws + WS_Z);
  float* st = (float*)(ws + WS_RSTD) + 3 * MPAD;
  const int lane = threadIdx.x & 63, wid = threadIdx.x >> 6, l16 = lane & 15, rsub = lane >> 4;
  for (int row = (vb * 4 + wid) * 4 + rsub; row < NTOK; row += G * 16) {
    const bf16* zr = Z + (size_t)row * ZLD1;
    float ssq = 0.f, sskv = 0.f;
#pragma unroll
    for (int i = 0; i < 4; ++i) { const u32x4 u = *(const u32x4*)(zr + 4096 + 32 * l16 + 8 * i);
      const float a0 = bflo(u.x), a1 = bfhi(u.x), a2 = bflo(u.y), a3 = bfhi(u.y), a4 = bflo(u.z), a5 = bfhi(u.z), a6 = bflo(u.w), a7 = bfhi(u.w);
      ssq += (a0 * a0 + a1 * a1) + (a2 * a2 + a3 * a3) + (a4 * a4 + a5 * a5) + (a6 * a6 + a7 * a7); }
#pragma unroll
    for (int i = 0; i < 2; ++i) { const u32x4 u = *(const u32x4*)(zr + 4608 + 16 * l16 + 8 * i);
      const float a0 = bflo(u.x), a1 = bfhi(u.x), a2 = bflo(u.y), a3 = bfhi(u.y), a4 = bflo(u.z), a5 = bfhi(u.z), a6 = bflo(u.w), a7 = bfhi(u.w);
      sskv += (a0 * a0 + a1 * a1) + (a2 * a2 + a3 * a3) + (a4 * a4 + a5 * a5) + (a6 * a6 + a7 * a7); }
    const u32x2 kru = *(const u32x2*)(zr + 4864 + 4 * l16);
    const float k0 = bflo(kru.x), k1 = bfhi(kru.x), k2 = bflo(kru.y), k3 = bfhi(kru.y);
    float sskr = (k0 * k0 + k1 * k1) + (k2 * k2 + k3 * k3);
#pragma unroll
    for (int d = 1; d < 16; d <<= 1) { ssq += __shfl_xor(ssq, d); sskv += __shfl_xor(sskv, d); sskr += __shfl_xor(sskr, d); }
    if (l16 == 0) { f32x4 o; o[0] = rsqrtf(ssq * (1.f / 512.f) + EPS); o[1] = rsqrtf(sskv * (1.f / 256.f) + EPS); o[2] = sskr; o[3] = 0.f; *(f32x4*)(st + (size_t)row * 4) = o; }
  }
}
DEVI void mla_prep_item(const Params& p, int item, char* lds) {
  unsigned char* ws = p.ws;
  const bf16* Z = (const bf16*)(ws + WS_Z);
  const bf16* qraw = (const bf16*)(ws + WS_QRAW);
  const bf16* kvraw = (const bf16*)(ws + WS_KVRAW);
  bf16* Qh = (bf16*)(ws + WS_QH); bf16* Kh = (bf16*)(ws + WS_KH); bf16* Vt = (bf16*)(ws + WS_VT);
  const int tid = threadIdx.x, lane = tid & 63, wid = tid >> 6, l16 = lane & 15, rsub = lane >> 4;
  const int hh = item & 7, tt = (item >> 3) % 33, b = item / (8 * 33);
  const float* gq = p.in[21]; const float* gk = p.in[22];
  f32x4 gqn0 = *(const f32x4*)(gq + 8 * l16), gqn1 = *(const f32x4*)(gq + 8 * l16 + 4), gqr = *(const f32x4*)(gq + 128 + 4 * l16);
  f32x4 gkn0 = *(const f32x4*)(gk + 8 * l16), gkn1 = *(const f32x4*)(gk + 8 * l16 + 4), gkr = *(const f32x4*)(gk + 128 + 4 * l16);
#pragma unroll 2
  for (int iter = 0; iter < 4; ++iter) {
    const int tl = 16 * wid + 4 * iter + rsub, t = 64 * tt + tl;
    const bool valid = t < T;
    const int row = b * T + (valid ? t : T - 1);
    const bf16* zr = Z + (size_t)row * ZLD1;
    const f32x4 stv = *(const f32x4*)((const float*)(ws + WS_RSTD) + 3 * MPAD + (size_t)row * 4);
    const float rcq = stv[0], rckv = stv[1], sskr = stv[2];
    const u32x2 kru = *(const u32x2*)(zr + 4864 + 4 * l16);
    float kr[4] = {bflo(kru.x), bfhi(kru.x), bflo(kru.y), bfhi(kru.y)};
    float cs_[4], sn_[4];
#pragma unroll
    for (int e = 0; e < 4; ++e) rope_cs((float)t, (4 * l16 + e) & 31, cs_[e], sn_[e]);
    const bool first_half = l16 < 8;
    const size_t orow = ((size_t)(b * 8 + hh) * TP + t) * 192;
    {
      const u32x4 un = *(const u32x4*)(qraw + (size_t)row * 1536 + hh * 192 + 8 * l16);
      const u32x2 ur = *(const u32x2*)(qraw + (size_t)row * 1536 + hh * 192 + 128 + 4 * l16);
      float qn[8] = {bflo(un.x) * rcq, bfhi(un.x) * rcq, bflo(un.y) * rcq, bfhi(un.y) * rcq, bflo(un.z) * rcq, bfhi(un.z) * rcq, bflo(un.w) * rcq, bfhi(un.w) * rcq};
      float qr[4] = {bflo(ur.x) * rcq, bfhi(ur.x) * rcq, bflo(ur.y) * rcq, bfhi(ur.y) * rcq};
      float ss = 0.f;
#pragma unroll
      for (int e = 0; e < 8; ++e) ss += qn[e] * qn[e];
#pragma unroll
      for (int e = 0; e < 4; ++e) ss += qr[e] * qr[e];
#pragma unroll
      for (int d = 1; d < 16; d <<= 1) ss += __shfl_xor(ss, d);
      const float rq = rsqrtf(ss * (1.f / 192.f) + EPS) * (valid ? 1.f : 0.f);
      const float sc = rq * QSCALE;
      u32x4 on; on.x = pk2(qn[0] * sc * gqn0[0], qn[1] * sc * gqn0[1]); on.y = pk2(qn[2] * sc * gqn0[2], qn[3] * sc * gqn0[3]);
      on.z = pk2(qn[4] * sc * gqn1[0], qn[5] * sc * gqn1[1]); on.w = pk2(qn[6] * sc * gqn1[2], qn[7] * sc * gqn1[3]);
      float ro[4];
#pragma unroll
      for (int e = 0; e < 4; ++e) {
        const float mine = qr[e] * sc * gqr[e];
        const float other = __shfl_xor(mine, 8);
        ro[e] = first_half ? (mine * cs_[e] - other * sn_[e]) : (other * sn_[e] + mine * cs_[e]);
      }
      u32x2 orr; orr.x = pk2(ro[0], ro[1]); orr.y = pk2(ro[2], ro[3]);
      if (t < TP) { *(u32x4*)(Qh + orow + 8 * l16) = on; *(u32x2*)(Qh + orow + 128 + 4 * l16) = orr; }
    }
    {
      const u32x4 un = *(const u32x4*)(kvraw + (size_t)row * 2048 + hh * 256 + 8 * l16);
      const u32x4 uv = *(const u32x4*)(kvraw + (size_t)row * 2048 + hh * 256 + 128 + 8 * l16);
      float kn[8] = {bflo(un.x) * rckv, bfhi(un.x) * rckv, bflo(un.y) * rckv, bfhi(un.y) * rckv, bflo(un.z) * rckv, bfhi(un.z) * rckv, bflo(un.w) * rckv, bfhi(un.w) * rckv};
      float ss = 0.f;
#pragma unroll
      for (int e = 0; e < 8; ++e) ss += kn[e] * kn[e];
#pragma unroll
      for (int d = 1; d < 16; d <<= 1) ss += __shfl_xor(ss, d);
      const float rk = rsqrtf((ss + sskr) * (1.f / 192.f) + EPS) * (valid ? 1.f : 0.f);
      u32x4 on; on.x = pk2(kn[0] * rk * gkn0[0], kn[1] * rk * gkn0[1]); on.y = pk2(kn[2] * rk * gkn0[2], kn[3] * rk * gkn0[3]);
      on.z = pk2(kn[4] * rk * gkn1[0], kn[5] * rk * gkn1[1]); on.w = pk2(kn[6] * rk * gkn1[2], kn[7] * rk * gkn1[3]);
      float ro[4];
#pragma unroll
      for (int e = 0; e < 4; ++e) {
        const float mine = kr[e] * rk * gkr[e];
        const float other = __shfl_xor(mine, 8);
        ro[e] = first_half ? (mine * cs_[e] - other * sn_[e]) : (other * sn_[e] + mine * cs_[e]);
      }
      u32x2 orr; orr.x = pk2(ro[0], ro[1]); orr.y = pk2(ro[2], ro[3]);
      if (t < TP) { *(u32x4*)(Kh + orow + 8 * l16) = on; *(u32x2*)(Kh + orow + 128 + 4 * l16) = orr; }
      const float vsc = valid ? rckv : 0.f;
      const float vv[8] = {bflo(uv.x) * vsc, bfhi(uv.x) * vsc, bflo(uv.y) * vsc, bfhi(uv.y) * vsc, bflo(uv.z) * vsc, bfhi(uv.z) * vsc, bflo(uv.w) * vsc, bfhi(uv.w) * vsc};
      const int x = tl & 15, pos = (tl & ~15) + 8 * ((x >> 2) & 1) + 4 * (x >> 3) + (x & 3);
#pragma unroll
      for (int e = 0; e < 8; ++e) *(bf16*)(lds + (8 * l16 + e) * 128 + pos * 2) = (bf16)f2bf(vv[e]);
    }
  }
  __syncthreads();
  {
    const int v = tid >> 1, half = tid & 1;
    bf16* dst = Vt + ((size_t)(b * 8 + hh) * 128 + v) * TP + 64 * tt + 32 * half;
    const char* s = lds + v * 128 + 64 * half;
#pragma unroll
    for (int i = 0; i < 4; ++i) *(u32x4*)(dst + 8 * i) = *(const u32x4*)(s + 16 * i);
  }
  __syncthreads();
}

DEVI void attn_item(const Params& p, int b, int hh, int qb, char* lds) {
  unsigned char* ws = p.ws;
  const bf16* Qh = (const bf16*)(ws + WS_QH); const bf16* Kh = (const bf16*)(ws + WS_KH); const bf16* Vt = (const bf16*)(ws + WS_VT);
  bf16* Y = (bf16*)(ws + WS_Y);
  const int tid = threadIdx.x, lane = tid & 63, wid = tid >> 6, l31 = lane & 31, hf = lane >> 5;
  const int tq = 128 * qb + 32 * wid + l31;
  const size_t bh = (size_t)(b * 8 + hh);
  bf16x8 qf[12];
  {
    const int tql = tq < T ? tq : T - 1;
    const bf16* qp = Qh + (bh * TP + tql) * 192 + 8 * hf;
#pragma unroll
    for (int s = 0; s < 12; ++s) qf[s] = u4_as_b8(*(const u32x4*)(qp + 16 * s));
  }
  f32x16 oacc[4];
#pragma unroll
  for (int v = 0; v < 4; ++v)
#pragma unroll
    for (int r = 0; r < 16; ++r) oacc[v][r] = 0.f;
  float m_run = -1e30f, l_run = 0.f;
  int nkt = 2 * qb + 2; if (nkt > 33) nkt = 33;
  char* VT = lds + 49152;
  const bf16* kbase = Kh + bh * TP * 192;
  const bf16* vbase = Vt + bh * 128 * TP;
  int ksrc[3];
#pragma unroll
  for (int j = 0; j < 3; ++j) { const int X = j * 256 + tid, r = X / 24, cp = X - 24 * r, c = (cp & ~7) | ((cp & 7) ^ ((r >> 1) & 7)); ksrc[j] = r * 192 + 8 * c; }
#define A_KDMA(kt_, buf_) do { _Pragma("unroll") for (int j = 0; j < 6; ++j) \
      __builtin_amdgcn_global_load_lds((const unsigned*)(kbase + (size_t)(64 * (kt_) + (j >= 3 ? 32 : 0)) * 192 + ksrc[j % 3]), (LAS unsigned*)(lds + (buf_) * 24576 + (4 * j + wid) * 1024), 16, 0, 0); } while (0)
  int vsrc0;
  { const int v_ = tid >> 3, cp = tid & 7, c = cp ^ ((v_ >> 1) & 7); vsrc0 = v_ * TP + 8 * c; }
#define A_VDMA(kt_) do { _Pragma("unroll") for (int j = 0; j < 4; ++j) \
      __builtin_amdgcn_global_load_lds((const unsigned*)(vbase + 64 * (kt_) + (size_t)(32 * j) * TP + vsrc0), (LAS unsigned*)(lds + 49152 + (4 * j + wid) * 1024), 16, 0, 0); } while (0)
  A_KDMA(0, 0);
  for (int kt = 0; kt < nkt; ++kt) {
    const char* KT = lds + (kt & 1) * 24576;
    asm volatile("s_waitcnt vmcnt(0)" ::: "memory");
    __syncthreads();
    A_VDMA(kt);
    { const int kn = kt + 1 < nkt ? kt + 1 : kt; A_KDMA(kn, (kt + 1) & 1); }
    __builtin_amdgcn_sched_barrier(0);
    const bool active = 64 * kt <= 128 * qb + 32 * wid + 31;
    bf16x8 pb[4];
    float alpha = 1.f;
    if (active) {
      f32x16 sacc[2];
#pragma unroll
      for (int i = 0; i < 2; ++i)
#pragma unroll
        for (int r = 0; r < 16; ++r) sacc[i][r] = 0.f;
#pragma unroll
      for (int s = 0; s < 12; ++s) {
        const int c = 2 * s + hf;
#pragma unroll
        for (int i = 0; i < 2; ++i) {
          const int r = 32 * i + l31;
          const bf16x8 a = *(const bf16x8*)(KT + r * 384 + (((c & ~7) | ((c & 7) ^ ((r >> 1) & 7))) << 4));
          sacc[i] = mfma32(a, qf[s], sacc[i]);
        }
      }
      if (64 * kt + 63 > 128 * qb + 32 * wid) {
#pragma unroll
        for (int i = 0; i < 2; ++i)
#pragma unroll
          for (int r = 0; r < 16; ++r) { const int key = 64 * kt + 32 * i + (r & 3) + 8 * (r >> 2) + 4 * hf; if (key > tq) sacc[i][r] = -1e30f; }
      }
      float mx = -1e30f;
#pragma unroll
      for (int i = 0; i < 2; ++i)
#pragma unroll
        for (int r = 0; r < 16; ++r) mx = fmaxf(mx, sacc[i][r]);
      mx = fmaxf(mx, __shfl_xor(mx, 32));
      const float m_new = fmaxf(m_run, mx);
      alpha = __builtin_amdgcn_exp2f(m_run - m_new);
      float psum = 0.f;
#pragma unroll
      for (int i = 0; i < 2; ++i)
#pragma unroll
        for (int r = 0; r < 16; ++r) { const float pv = __builtin_amdgcn_exp2f(sacc[i][r] - m_new); sacc[i][r] = pv; psum += pv; }
      psum += __shfl_xor(psum, 32);
      l_run = l_run * alpha + psum; m_run = m_new;
#pragma unroll
      for (int ks = 0; ks < 4; ++ks) {
        const int i = ks >> 1, s0 = 8 * (ks & 1);
        u32x4 pu; pu.x = pk2(sacc[i][s0 + 0], sacc[i][s0 + 1]); pu.y = pk2(sacc[i][s0 + 2], sacc[i][s0 + 3]); pu.z = pk2(sacc[i][s0 + 4], sacc[i][s0 + 5]); pu.w = pk2(sacc[i][s0 + 6], sacc[i][s0 + 7]);
        pb[ks] = u4_as_b8(pu);
      }
    } else {
#pragma unroll
      for (int ks = 0; ks < 4; ++ks) pb[ks] = u4_as_b8((u32x4){0u, 0u, 0u, 0u});
    }
    asm volatile("s_waitcnt vmcnt(0)" ::: "memory");
    __syncthreads();
    if (active) {
#pragma unroll
      for (int v = 0; v < 4; ++v)
#pragma unroll
        for (int r = 0; r < 16; ++r) oacc[v][r] *= alpha;
#pragma unroll
      for (int ks = 0; ks < 4; ++ks) {
        const int c = 2 * ks + hf;
#pragma unroll
        for (int v = 0; v < 4; ++v) {
          const int r = 32 * v + l31;
          const bf16x8 a = *(const bf16x8*)(VT + r * 128 + ((c ^ ((r >> 1) & 7)) << 4));
          oacc[v] = mfma32(a, pb[ks], oacc[v]);
        }
      }
    }
  }
  __syncthreads();
#undef A_KDMA
#undef A_VDMA
  if (tq < T) {
    const float inv = 1.f / l_run;
    bf16* dst = Y + (size_t)(b * T + tq) * D + 1024 + hh * 128 + 4 * hf;
#pragma unroll
    for (int v = 0; v < 4; ++v)
#pragma unroll
      for (int q4 = 0; q4 < 4; ++q4) {
        u32x2 o; o.x = pk2(oacc[v][4 * q4 + 0] * inv, oacc[v][4 * q4 + 1] * inv); o.y = pk2(oacc[v][4 * q4 + 2] * inv, oacc[v][4 * q4 + 3] * inv);
        *(u32x2*)(dst + 32 * v + 8 * q4) = o;
      }
  }
}

struct MoeSrc1 {
  const Params& p; int layer; const int* ioff; const int* itp; const int* icnt;
  DEVI void locate(int L, int& e, int& mt, int& nt, int& nvalid) const {
    const int mtg = L >> 3; nt = L & 7; e = 0;
    while (itp[e + 1] <= mtg) ++e;
    mt = mtg - itp[e]; nvalid = icnt[e] - mt * 128; if (nvalid > 128) nvalid = 128;
  }
  DEVI void tile(int L, TileDesc& d) const {
    int e, mt, nt, nvalid; locate(L, e, mt, nt, nvalid);
    unsigned char* ws = p.ws;
    d.A = (const bf16*)(ws + WS_XN); d.lda = D; d.rows = (const int*)(ws + WS_LIST) + (size_t)e * NTOK + mt * 128; d.nvalid = nvalid; d.arow0 = 0;
    d.Bt = (const bf16*)(ws + (layer ? WS_W13B : WS_W13)) + ((size_t)e * 1024 + nt * 128) * 2048; d.ldb = 2048; d.K = 2048;
  }
  DEVI void epilogue(int L, const f32x4 (&acc)[4][4], int wm, int wn, int lane) const {
    int e, mt, nt, nvalid; locate(L, e, mt, nt, nvalid);
    unsigned char* ws = p.ws;
    EpiMoe1 epi{(bf16*)(ws + WS_HBUF), (const int*)(ws + WS_LIST) + (size_t)e * NTOK + mt * 128, (const float*)(ws + WS_RSTD) + 2 * MPAD, nvalid, ioff[e] + mt * 128, nt * 64};
    epi(acc, wm, wn, lane);
  }
};
struct MoeSrc2 {
  const Params& p; int layer; const int* ioff; const int* itp; const int* icnt;
  DEVI void locate(int L, int& e, int& mt, int& nt, int& nvalid) const {
    const int mtg = L >> 4; nt = L & 15; e = 0;
    while (itp[e + 1] <= mtg) ++e;
    mt = mtg - itp[e]; nvalid = icnt[e] - mt * 128; if (nvalid > 128) nvalid = 128;
  }
  DEVI void tile(int L, TileDesc& d) const {
    int e, mt, nt, nvalid; locate(L, e, mt, nt, nvalid);
    unsigned char* ws = p.ws;
    d.A = (const bf16*)(ws + WS_HBUF); d.lda = 512; d.rows = nullptr; d.nvalid = 128; d.arow0 = ioff[e] + mt * 128;
    d.Bt = (const bf16*)(ws + (layer ? WS_W2B : WS_W2)) + ((size_t)e * 2048 + nt * 128) * 512; d.ldb = 512; d.K = 512;
  }
  DEVI void epilogue(int L, const f32x4 (&acc)[4][4], int wm, int wn, int lane) const {
    int e, mt, nt, nvalid; locate(L, e, mt, nt, nvalid);
    unsigned char* ws = p.ws;
    EpiMoe2 epi{(bf16*)(ws + WS_YMOE), (const float*)(ws + WS_GLIST) + (size_t)e * NTOK + mt * 128, nvalid, ioff[e] + mt * 128, nt * 128};
    epi(acc, wm, wn, lane);
  }
};
struct MoeSrc1Half {
  const Params& p; int layer; const int* ioff; const int* itp; const int* icnt; int full;
  DEVI void locate(int it, int& hb, int& e, int& mt, int& nt, int& nvalid) const {
    const int L = full + (it >> 1); hb = it & 1;
    const int mtg = L >> 3; nt = L & 7; e = 0;
    while (itp[e + 1] <= mtg) ++e;
    mt = mtg - itp[e]; nvalid = icnt[e] - mt * 128; if (nvalid > 128) nvalid = 128;
  }
  DEVI void tile(int it, TileDesc& d) const {
    int hb, e, mt, nt, nvalid; locate(it, hb, e, mt, nt, nvalid);
    unsigned char* ws = p.ws;
    d.A = (const bf16*)(ws + WS_XN); d.lda = D; d.rows = (const int*)(ws + WS_LIST) + (size_t)e * NTOK + mt * 128; d.nvalid = nvalid; d.arow0 = 0;
    d.Bt = (const bf16*)(ws + (layer ? WS_W13B : WS_W13)) + ((size_t)e * 1024 + nt * 128 + hb * 64) * 2048; d.ldb = 2048; d.K = 2048;
  }
  DEVI void epilogue_half(int it, const f32x4 (&acc)[2][4], int wid, int lane) const {
    int hb, e, mt, nt, nvalid; locate(it, hb, e, mt, nt, nvalid);
    unsigned char* ws = p.ws;
    const int* rows = (const int*)(ws + WS_LIST) + (size_t)e * NTOK + mt * 128;
    const float* rs = (const float*)(ws + WS_RSTD) + 2 * MPAD;
    bf16* hb_ = (bf16*)(ws + WS_HBUF);
    const int slot0 = ioff[e] + mt * 128, c0 = nt * 64 + hb * 32;
#pragma unroll
    for (int i = 0; i < 2; ++i) {
      const int rl = wid * 32 + 16 * i + (lane & 15);
      if (rl < nvalid) {
        const float s = rs[rows[rl]];
#pragma unroll
        for (int jj = 0; jj < 2; ++jj) {
          float v[4];
#pragma unroll
          for (int r = 0; r < 4; ++r) { const float a = acc[i][2 * jj][r] * s, b = acc[i][2 * jj + 1][r] * s; v[r] = siluf_(a) * b; }
          u32x2 o; o.x = pk2(v[0], v[1]); o.y = pk2(v[2], v[3]);
          *(u32x2*)(hb_ + (size_t)(slot0 + rl) * 512 + c0 + 16 * jj + 4 * (lane >> 4)) = o;
        }
      }
    }
  }
};
DEVI void moe_gemm1(const Params& p, int layer, int vb, int G, char* lds) {
  unsigned char* ws = p.ws;
  int* ioff = (int*)(lds + 65536); int* itp = ioff + 40; int* icnt = itp + 40;
  moe_offsets((const int*)(ws + WS_CTL) + CT_CNT + layer * NE, ioff, itp, icnt);
  const int total = itp[NE] * 8, full = (total / G) * G, rem = total - full;
  MoeSrc1 src{p, layer, ioff, itp, icnt};
  gemm_loop(src, vb, G, full, lds);
  if (rem > 0) { MoeSrc1Half hs{p, layer, ioff, itp, icnt, full}; gemm_loop_half(hs, vb, G, rem * 2, lds); }
}
DEVI void moe_gemm2(const Params& p, int layer, int vb, int G, char* lds) {
  unsigned char* ws = p.ws;
  int* ioff = (int*)(lds + 65536); int* itp = ioff + 40; int* icnt = itp + 40;
  moe_offsets((const int*)(ws + WS_CTL) + CT_CNT + layer * NE, ioff, itp, icnt);
  MoeSrc2 src{p, layer, ioff, itp, icnt};
  gemm_loop(src, vb, G, itp[NE] * 16, lds);
}

constexpr int NPHASE = 20;
__global__ void __launch_bounds__(NTHR, 2) mega(Params p) {
  extern __shared__ __attribute__((aligned(16))) char lds[];
  cg::grid_group grid = cg::this_grid();
  const int G = gridDim.x, bx = blockIdx.x, vb = vcu_of(bx, G);
  unsigned char* ws = p.ws;
  float* rstd = (float*)(ws + WS_RSTD);
  const int lo = p.ph_lo, hi = p.ph_hi;
  volatile LAS unsigned* xst = (volatile LAS unsigned*)(LAS char*)(lds + LDS_BYTES - 64);
  if (threadIdx.x < 2) xst[threadIdx.x] = 0u;
  __syncthreads();
  XcdBarrier xbar; xbar.bar = (unsigned*)(ws + WS_CTL) + CT_BAR; xbar.x = 0; xbar.st = xst;
  if (hi - lo > 1) xbar = xcd_barrier_post((unsigned*)(ws + WS_CTL) + CT_BAR, xst);
#ifdef ONLY
#define IN(k) ((k) == ONLY && lo <= (k) && (k) < hi)
#else
#define IN(k) (lo <= (k) && (k) < hi)
#endif
#ifdef USE_COOP
#define SEAM(k) do { if (IN(k) && IN((k) + 1)) { if ((k) == 0) grid.sync(); else xcd_barrier(xbar); } } while (0)
#else
#define SEAM(k) do { if (IN(k) && IN((k) + 1)) { xcd_barrier(xbar); } } while (0)
#endif
#ifdef EXTRA_SYNC
  for (int i_ = 0; i_ < EXTRA_SYNC; ++i_) xcd_barrier(xbar);
#endif
  if (IN(0)) { dense_transposes(p, vb, G, lds); pack_small(p, vb, G); }
  SEAM(0);
  if (IN(1)) rowpass<0, 1>(p, p.in[2], rstd, (const bf16*)(ws + WS_WPK), 0, bx, G, lds);
  SEAM(1);
  if (IN(2)) inproj0_phase(p, vb, G, lds);
  SEAM(2);
  if (IN(3)) {
    int* ctr = (int*)(ws + WS_CTL) + CT_WQ + 0; int* slot = (int*)(lds + LDS_BYTES - 32);
    for (int it = next_item(ctr, slot); it < 1056; it = next_item(ctr, slot)) { if (it < 528) gla_prep<false>(p, it, lds); else mlstm_prep(p, it - 528, lds); }
  }
  SEAM(3);
  if (IN(4)) {
    if (!(p.flags & 2)) {
    for (int it = bx; it < 64; it += G) mlstm_item(p, it, lds);
    for (int it = bx; it < 128; it += G) if (it >= 64) gla_item<false>(p, it - 64, lds);
    }
    if (!(p.flags & 1) && hi - lo > 1) { FillState fst; fst.pos = 0; fst.end = 0; fst.active = true; while (fill_step(p, lds, fst)) {} }
  }
  SEAM(4);
  if (IN(5)) yfin_rows<false>(p, bx * 4 + (threadIdx.x >> 6), G * 4, NTOK);
  SEAM(5);
  if (IN(6)) {
    outproj_phase((const bf16*)(ws + WS_Y), (const bf16*)(ws + WS_WOUT0), (bf16*)(ws + WS_H), ws, 0, vb, G, lds);
  }
  SEAM(6);
  if (IN(7)) rowpass<2, 2>(p, p.in[24], rstd + 2 * MPAD, (const bf16*)(ws + WS_WPK + 131072), 0, bx, G, lds);
  SEAM(7);
  if (IN(8)) moe_gemm1(p, 0, vb, G, lds);
  SEAM(8);
  if (IN(9)) moe_gemm2(p, 0, vb, G, lds);
  SEAM(9);
  if (IN(10)) rowpass<1, 0>(p, p.in[13], rstd + MPAD, nullptr, 0, bx, G, lds);
  SEAM(10);
  if (IN(11)) {
    gemm_phase((const bf16*)(ws + WS_XN), D, (const bf16*)(ws + WS_WIN1), 2048, ZLD1, vb, G, lds,
               [&](int m0, int n0) { return EpiBf16{(bf16*)(ws + WS_Z), ZLD1, rstd + MPAD, m0, n0, NTOK}; });
  }
  SEAM(11);
  if (IN(12)) {
    mla_row_stats(p, vb, G);
    struct UpSrc { unsigned char* ws;
      DEVI void tile(int L, TileDesc& d) const {
        const int n1 = (MPAD / 128) * 12; int pm, pn;
        if (L < n1) { tile_of(L, MPAD / 128, 12, pm, pn); d.A = (const bf16*)(ws + WS_Z) + 4096; d.Bt = (const bf16*)(ws + WS_WQ) + (size_t)pn * 128 * 512; d.ldb = 512; d.K = 512; }
        else { tile_of(L - n1, MPAD / 128, 16, pm, pn); d.A = (const bf16*)(ws + WS_Z) + 4608; d.Bt = (const bf16*)(ws + WS_WKV) + (size_t)pn * 128 * 256; d.ldb = 256; d.K = 256; }
        d.lda = ZLD1; d.rows = nullptr; d.nvalid = 128; d.arow0 = pm * 128;
      }
      DEVI void epilogue(int L, const f32x4 (&acc)[4][4], int wm, int wn, int lane) const {
        const int n1 = (MPAD / 128) * 12; int pm, pn;
        if (L < n1) { tile_of(L, MPAD / 128, 12, pm, pn); EpiBf16 e{(bf16*)(ws + WS_QRAW), 1536, nullptr, pm * 128, pn * 128, NTOK}; e(acc, wm, wn, lane); }
        else { tile_of(L - n1, MPAD / 128, 16, pm, pn); EpiBf16 e{(bf16*)(ws + WS_KVRAW), 2048, nullptr, pm * 128, pn * 128, NTOK}; e(acc, wm, wn, lane); }
      } };
    UpSrc src{ws};
    gemm_loop(src, vb, G, (MPAD / 128) * 28, lds);
  }
  SEAM(12);
  if (IN(13)) {
    int* ctr = (int*)(ws + WS_CTL) + CT_WQ + 16; int* slot = (int*)(lds + LDS_BYTES - 32);
    for (int it = next_item(ctr, slot); it < 1056 * 2; it = next_item(ctr, slot)) { if (it < 1056) mla_prep_item(p, it, lds); else gla_prep<true>(p, it - 1056, lds); }
  }
  SEAM(13);
  if (IN(14)) {
    if (!(p.flags & 2)) { for (int it = bx; it < 64; it += G) gla_item<true>(p, it, lds); }
    if (!(p.flags & 1)) { int* ctr = (int*)(ws + WS_CTL) + CT_WQ + 32; int* slot = (int*)(lds + LDS_BYTES - 32);
      if (hi - lo > 1) { for (int a = next_item(ctr, slot); a < 544; a = next_item(ctr, slot)) attn_item(p, (a & 31) >> 3, a & 7, 16 - (a >> 5), lds); }
      else { for (int a = bx; a < 544; a += G) attn_item(p, (a & 31) >> 3, a & 7, 16 - (a >> 5), lds); } }
  }
  SEAM(14);
  if (IN(15)) yfin_rows<true>(p, bx * 4 + (threadIdx.x >> 6), G * 4, NTOK);
  SEAM(15);
  if (IN(16)) {
    outproj_phase((const bf16*)(ws + WS_Y), (const bf16*)(ws + WS_WOUT1), (bf16*)(ws + WS_H), ws, 1, vb, G, lds);
  }
  SEAM(16);
  if (IN(17)) rowpass<2, 2>(p, p.in[24] + D, rstd + 2 * MPAD, (const bf16*)(ws + WS_WPK + 131072 + 196608), 1, bx, G, lds);
  SEAM(17);
  if (IN(18)) moe_gemm1(p, 1, vb, G, lds);
  SEAM(18);
  if (IN(19)) moe_gemm2(p, 1, vb, G, lds);
  SEAM(19);
  if (IN(20)) final_combine(p, vb, G, lds);
#undef IN
#undef SEAM
}

#ifndef MK_MULTI
#define MK_MULTI 0
#endif
extern "C" void kernel_launch(void* const* d_in, const int* in_sizes, int n_in, void* d_out, int out_size,
                              void* d_ws, size_t ws_size, hipStream_t stream) {
  static int grid_blocks = 0;
  if (!grid_blocks) {
    int dev = 0, cus = 0, per_cu = 0;
    (void)hipGetDevice(&dev);
    (void)hipDeviceGetAttribute(&cus, hipDeviceAttributeMultiprocessorCount, dev);
    (void)hipFuncSetAttribute((const void*)mega, hipFuncAttributeMaxDynamicSharedMemorySize, LDS_BYTES);
    (void)hipOccupancyMaxActiveBlocksPerMultiprocessor(&per_cu, mega, NTHR, (size_t)LDS_BYTES);
    if (per_cu < 1) per_cu = 1;
    if (per_cu > 2) per_cu = 2;
    grid_blocks = cus * per_cu;
    if (n_in != 32 || ws_size < WS_END) fprintf(stderr, "kernel_launch: unexpected n_in %d / ws %zu (need %zu)\n", n_in, ws_size, (size_t)WS_END);
    fprintf(stderr, "mega: cus %d per_cu %d grid %d ws %zu\n", cus, per_cu, grid_blocks, ws_size);
  }
  (void)hipMemsetAsync((char*)d_ws + WS_CTL, 0, CTL_BYTES, stream);
  Params p{};
  for (int i = 0; i < 32; ++i) p.in[i] = (const float*)d_in[i];
  p.out = (float*)d_out; p.ws = (unsigned char*)d_ws;
#if MK_MULTI
  for (int ph = 0; ph <= NPHASE; ++ph) {
    p.ph_lo = ph; p.ph_hi = ph + 1;
    hipLaunchKernelGGL(mega, dim3(grid_blocks), dim3(NTHR), LDS_BYTES, stream, p);
  }
#else
  p.ph_lo = 0; p.ph_hi = NPHASE + 1;
  void* args[] = {&p};
#ifdef USE_COOP
  hipError_t e = hipLaunchCooperativeKernel((void*)mega, dim3(grid_blocks), dim3(NTHR), args, LDS_BYTES, stream);
#else
  hipLaunchKernelGGL(mega, dim3(grid_blocks), dim3(NTHR), LDS_BYTES, stream, p);
  hipError_t e = hipPeekAtLastError();
#endif
  if (e != hipSuccess) fprintf(stderr, "cooperative launch failed: %s (grid %d)\n", hipGetErrorString(e), grid_blocks);
#ifdef PROBE_PHASE
  for (int rep = 0; rep < PROBE_REPS; ++rep) {
    Params q = p; q.ph_lo = PROBE_PHASE; q.ph_hi = PROBE_PHASE + 1; q.flags = PROBE_FLAGS;
    void* args2[] = {&q};
    (void)hipLaunchCooperativeKernel((void*)mega, dim3(grid_blocks), dim3(NTHR), args2, LDS_BYTES, stream);
  }
#endif
#endif
}
```

```cpp
#include <hip/hip_runtime.h>
#include <hip/hip_cooperative_groups.h>
#include <cstdio>
#include <cstdint>
namespace cg = cooperative_groups;

#define DEVI __device__ __forceinline__
typedef unsigned short bf16;
typedef short bf16x8 __attribute__((ext_vector_type(8)));
typedef short s16x4 __attribute__((ext_vector_type(4)));
typedef float f32x4 __attribute__((ext_vector_type(4)));
typedef float f32x16 __attribute__((ext_vector_type(16)));
typedef unsigned u32x4 __attribute__((ext_vector_type(4)));
typedef unsigned u32x2 __attribute__((ext_vector_type(2)));
#define LAS __attribute__((address_space(3)))

constexpr int NB = 4, SEQ = 2048, NMETA = 16, T = 2064, NTOK = NB * T, D = 2048, MPAD = 8320;
constexpr int ZLD0 = 6144, ZLD1 = 4992;
constexpr int TP = 2112;
constexpr float EPS = 1e-6f;
constexpr int NE = 32;
constexpr int NTHR = 256;
constexpr int LDS_BYTES = 79936;

constexpr size_t MiB = 1u << 20;
constexpr size_t WS_CTL = 0;
constexpr size_t WS_RSTD = 1 * MiB;
constexpr size_t WS_GATES = 2 * MiB;
constexpr size_t WS_TOKE = 4 * MiB;
constexpr size_t WS_LIST = 5 * MiB;
constexpr size_t WS_GLIST = 7 * MiB;
constexpr size_t WS_WPK = 9 * MiB;
constexpr size_t WS_H = 10 * MiB;
constexpr size_t WS_XN = 76 * MiB;
constexpr size_t WS_Z = 110 * MiB;
constexpr size_t WS_HRAW = 208 * MiB;
constexpr size_t WS_Y = 242 * MiB;
constexpr size_t WS_HBUF = 276 * MiB;
constexpr size_t WS_YMOE = 294 * MiB;
constexpr size_t WS_QRAW = 360 * MiB;
constexpr size_t WS_KVRAW = 386 * MiB;
constexpr size_t WS_QH = 420 * MiB;
constexpr size_t WS_KH = 446 * MiB;
constexpr size_t WS_VT = 472 * MiB;
constexpr size_t WS_WIN0 = 490 * MiB;
constexpr size_t WS_WOUT0 = 516 * MiB;
constexpr size_t WS_WIN1 = 525 * MiB;
constexpr size_t WS_WOUT1 = 546 * MiB;
constexpr size_t WS_WQ = 555 * MiB;
constexpr size_t WS_WKV = 557 * MiB;
constexpr size_t WS_W13 = 560 * MiB;
constexpr size_t WS_W2 = 694 * MiB;
constexpr size_t WS_PQK = 762 * MiB;
constexpr size_t WS_PVEC = 798 * MiB;
constexpr size_t WS_W13B = 800 * MiB;
constexpr size_t WS_W2B = 934 * MiB;
constexpr size_t WS_ZT = 1001 * MiB;
constexpr size_t WS_END = 1014 * MiB;

constexpr int CT_CNT = 4608;
constexpr int CSTR = 32;
constexpr int CT_BAR = 1024;
constexpr int CT_SPLITZ = 512;
constexpr int CT_WQ = 64;
constexpr int CTL_BYTES = 32768;

struct Params {
  const float* in[32];
  float* out;
  unsigned char* ws;
  int ph_lo, ph_hi, flags, pad;
};

DEVI unsigned f2bf(float f) { unsigned u = __float_as_uint(f); return (u + 0x7fffu + ((u >> 16) & 1u)) >> 16; }
DEVI unsigned pk2(float lo, float hi) { return f2bf(lo) | (f2bf(hi) << 16); }
DEVI float bf2f(bf16 b) { return __uint_as_float(((unsigned)b) << 16); }
DEVI float bflo(unsigned u) { return __uint_as_float(u << 16); }
DEVI float bfhi(unsigned u) { return __uint_as_float(u & 0xffff0000u); }
DEVI float sigmoidf_(float x) { return 1.f / (1.f + __expf(-x)); }
DEVI float siluf_(float x) { return x / (1.f + __expf(-x)); }
DEVI float logsigmoidf_(float x) { return fminf(x, 0.f) - __logf(1.f + __expf(-fabsf(x))); }
DEVI f32x4 mfma16(bf16x8 a, bf16x8 b, f32x4 c) { return __builtin_amdgcn_mfma_f32_16x16x32_bf16(a, b, c, 0, 0, 0); }
DEVI f32x16 mfma32(bf16x8 a, bf16x8 b, f32x16 c) { return __builtin_amdgcn_mfma_f32_32x32x16_bf16(a, b, c, 0, 0, 0); }
DEVI bf16x8 u4_as_b8(u32x4 v) { return __builtin_bit_cast(bf16x8, v); }
DEVI s16x4 lds_tr16(const char* p) { return __builtin_amdgcn_ds_read_tr16_b64_v4i16((LAS s16x4*)(p)); }
DEVI bf16x8 cat4(s16x4 a, s16x4 b) { bf16x8 r; r[0] = a[0]; r[1] = a[1]; r[2] = a[2]; r[3] = a[3]; r[4] = b[0]; r[5] = b[1]; r[6] = b[2]; r[7] = b[3]; return r; }


#define XB_TMO      128
#define XB_XCNT(j)  (256  + 64 * (j))
#define XB_XSUB(j)  (1280 + 64 * (j))
#define XB_XGEN(j)  (2304 + 64 * (j))
#define XB_TOP      3328
#define XB_TOPGEN   3392
#define XCD_BAR_WORDS 3456
#define XB_SPIN_CAP (1u << 18)
DEVI unsigned xb_ld(unsigned* p)              { return __hip_atomic_load(p, __ATOMIC_RELAXED, __HIP_MEMORY_SCOPE_AGENT); }
DEVI unsigned xb_add(unsigned* p, unsigned v) { return __hip_atomic_fetch_add(p, v, __ATOMIC_RELAXED, __HIP_MEMORY_SCOPE_AGENT); }
DEVI unsigned xb_xcc_id() { return (unsigned)__builtin_amdgcn_s_getreg((3 << 11) | 20) & 0xFu; }
#define XB_SPIN(cond, bar) do { unsigned _sp = 0; while (cond) { __builtin_amdgcn_s_sleep(1); \
    if ((++_sp & 255u) == 0u) { if (xb_ld(&(bar)[XB_TMO])) break; if (_sp > XB_SPIN_CAP) { atomicAdd(&(bar)[XB_TMO], 1u); break; } } } } while (0)
struct XcdBarrier { unsigned* bar; unsigned x; volatile LAS unsigned* st; };
DEVI XcdBarrier xcd_barrier_post(unsigned* bar, volatile LAS unsigned* st) {
    XcdBarrier b; b.bar = bar; b.x = xb_xcc_id(); b.st = st;
    if (threadIdx.x == 0) (void)xb_add(&bar[XB_XCNT(b.x)], 1u);
    return b;
}
DEVI void xcd_barrier_complete(unsigned* bar, unsigned x, unsigned& nloc, unsigned& nx) {
    const unsigned G = gridDim.x * gridDim.y * gridDim.z;
    unsigned sum, cnt, mine, sp = 0u;
    for (;;) {
        sum = 0u; cnt = 0u; mine = 0u;
#pragma unroll
        for (unsigned j = 0; j < 16; ++j) { const unsigned c = xb_ld(&bar[XB_XCNT(j)]); sum += c; cnt += (c > 0u) ? 1u : 0u; mine = (j == x) ? c : mine; }
        if (sum == G) break;
        __builtin_amdgcn_s_sleep(1);
        if ((++sp & 255u) == 0u) { if (xb_ld(&bar[XB_TMO])) break; if (sp > XB_SPIN_CAP) { atomicAdd(&bar[XB_TMO], 1u); break; } }
    }
    nloc = mine > 0u ? mine : 1u; nx = cnt > 0u ? cnt : 1u;
}
DEVI void xcd_barrier(const XcdBarrier& b) {
    asm volatile("s_waitcnt vmcnt(0)" ::: "memory");
    __syncthreads();
    if (threadIdx.x == 0) {
        unsigned* bar = b.bar;
        __builtin_amdgcn_s_waitcnt(0);
        unsigned nloc = b.st[0], nx = b.st[1];
        if (nloc == 0u) { xcd_barrier_complete(bar, b.x, nloc, nx); b.st[0] = nloc; b.st[1] = nx; }
        const unsigned old = xb_add(&bar[XB_XSUB(b.x)], 1u);
        const unsigned gen = old / nloc;
        if (old + 1u == (gen + 1u) * nloc) {
            __builtin_amdgcn_fence(__ATOMIC_RELEASE, "agent");
            asm volatile("s_waitcnt vmcnt(0)" ::: "memory");
            const unsigned og = xb_add(&bar[XB_TOP], 1u);
            const unsigned tg = og / nx;
            if (og + 1u == (tg + 1u) * nx) xb_add(&bar[XB_TOPGEN], 1u);
            else XB_SPIN(xb_ld(&bar[XB_TOPGEN]) == tg, bar);
            __builtin_amdgcn_fence(__ATOMIC_ACQUIRE, "agent");
            xb_add(&bar[XB_XGEN(b.x)], 1u);
            asm volatile("s_waitcnt vmcnt(0)" ::: "memory");
        } else {
            XB_SPIN(xb_ld(&bar[XB_XGEN(b.x)]) == gen, bar);
            __builtin_amdgcn_fence(__ATOMIC_ACQUIRE, "agent");
            asm volatile("s_waitcnt vmcnt(0)" ::: "memory");
        }
    }
    __syncthreads();
}

DEVI int next_item(int* ctr, int* lds_slot) {
  __syncthreads();
  if (threadIdx.x == 0) *lds_slot = atomicAdd(ctr, 1);
  __syncthreads();
  return *lds_slot;
}

DEVI int vcu_of(int bx, int G) { return (G % 8 == 0) ? (bx % 8) * (G / 8) + bx / 8 : bx; }

DEVI void transpose_tile(const float* __restrict__ src, int ldsrc, int k0, int c0, int nrel0, bf16* __restrict__ dst, int ldd, int roff, bool il,
                         const float* __restrict__ kscale, char* lds) {
  float* tile = (float*)lds;
  const int tid = threadIdx.x;
  {
    const int col = tid & 63, kr = tid >> 6;
#pragma unroll
    for (int i = 0; i < 16; ++i) {
      const int k = kr + 4 * i;
      float v = src[(size_t)(k0 + k) * ldsrc + c0 + col];
      if (kscale) v *= kscale[k0 + k];
      tile[col * 65 + k] = v;
    }
  }
  __syncthreads();
  {
    const int n = tid >> 2, kq = tid & 3;
    const float* s = tile + n * 65 + 16 * kq;
    u32x4 o0, o1;
    o0.x = pk2(s[0], s[1]); o0.y = pk2(s[2], s[3]); o0.z = pk2(s[4], s[5]); o0.w = pk2(s[6], s[7]);
    o1.x = pk2(s[8], s[9]); o1.y = pk2(s[10], s[11]); o1.z = pk2(s[12], s[13]); o1.w = pk2(s[14], s[15]);
    const int nr = nrel0 + n;
    const int drow = il ? ((nr >> 4) * 32 + (nr & 15) + roff) : (nr + roff);
    bf16* d = dst + (size_t)drow * ldd + k0 + 16 * kq;
    *(u32x4*)d = o0; *(u32x4*)(d + 8) = o1;
  }
  __syncthreads();
}

DEVI void transpose_job_tile(const float* src, int ldsrc, int coff, int ncols, int K, bf16* dst, int roff, bool il, const float* kscale, int tidx, char* lds) {
  const int nt = ncols / 64;
  const int kt = tidx / nt, ntile = tidx % nt;
  transpose_tile(src, ldsrc, kt * 64, coff + ntile * 64, ntile * 64, dst, K, roff, il, kscale, lds);
}

constexpr int TJ0 = 1536, TJ1 = 1536, TJ2 = 1024, TJ3 = 2464, TJ4 = 1024, TJ5 = 192, TJ6 = 128;
constexpr int TJ_DENSE = TJ0 + TJ1 + TJ2 + TJ3 + TJ4 + TJ5 + TJ6;
constexpr int TJ_MOE = 24576;

DEVI void dense_transposes(const Params& p, int vb, int G, char* lds) {
  unsigned char* ws = p.ws;
  for (int it = vb; it < TJ_DENSE; it += G) {
    int r = it;
    if (r < TJ0) { transpose_job_tile(p.in[3], 6168, 0, 3072, 2048, (bf16*)(ws + WS_WIN0), 0, false, nullptr, r, lds); continue; } r -= TJ0;
    if (r < TJ1) { transpose_job_tile(p.in[3], 6168, 3080, 3072, 2048, (bf16*)(ws + WS_WIN0), 3072, false, nullptr, r, lds); continue; } r -= TJ1;
    if (r < TJ2) { transpose_job_tile(p.in[12], 2048, 0, 2048, 2048, (bf16*)(ws + WS_WOUT0), 0, false, nullptr, r, lds); continue; } r -= TJ2;
    if (r < TJ3) { transpose_job_tile(p.in[14], 4928, 0, 4928, 2048, (bf16*)(ws + WS_WIN1), 0, false, nullptr, r, lds); continue; } r -= TJ3;
    if (r < TJ4) { transpose_job_tile(p.in[23], 2048, 0, 2048, 2048, (bf16*)(ws + WS_WOUT1), 0, false, nullptr, r, lds); continue; } r -= TJ4;
    if (r < TJ5) { transpose_job_tile(p.in[18], 1536, 0, 1536, 512, (bf16*)(ws + WS_WQ), 0, false, p.in[17], r, lds); continue; } r -= TJ5;
    transpose_job_tile(p.in[20], 2048, 0, 2048, 256, (bf16*)(ws + WS_WKV), 0, false, p.in[19], r, lds);
  }
  {
    bf16* w = (bf16*)(ws + WS_WIN1) + (size_t)4928 * 2048;
    const int n16 = 64 * 2048 / 8;
    for (int i = vb * NTHR + threadIdx.x; i < n16; i += G * NTHR) ((u32x4*)w)[i] = (u32x4){0u, 0u, 0u, 0u};
  }
}
DEVI void moe_transposes(const Params& p, int layer, int vb, int G, char* lds) {
  unsigned char* ws = p.ws;
  const size_t W13 = layer ? WS_W13B : WS_W13, W2 = layer ? WS_W2B : WS_W2;
  for (int it = vb; it < TJ_MOE; it += G) {
    const int e = it / 768; int r = it % 768;
    if (r < 256) { transpose_job_tile(p.in[29] + ((size_t)(layer * NE + e)) * 2048 * 512, 512, 0, 512, 2048, (bf16*)(ws + W13) + (size_t)e * 1024 * 2048, 0, true, nullptr, r, lds); continue; } r -= 256;
    if (r < 256) { transpose_job_tile(p.in[30] + ((size_t)(layer * NE + e)) * 2048 * 512, 512, 0, 512, 2048, (bf16*)(ws + W13) + (size_t)e * 1024 * 2048, 16, true, nullptr, r, lds); continue; } r -= 256;
    transpose_job_tile(p.in[31] + ((size_t)(layer * NE + e)) * 512 * 2048, 2048, 0, 2048, 512, (bf16*)(ws + W2) + (size_t)e * 2048 * 512, 0, false, nullptr, r, lds);
  }
}

struct FillState { int pos, end; bool active; };
DEVI void moe_tile(const Params& p, int git, char* lds) {
  unsigned char* ws = p.ws;
  const int layer = git >= TJ_MOE ? 1 : 0, it = git - layer * TJ_MOE;
  const size_t W13 = layer ? WS_W13B : WS_W13, W2 = layer ? WS_W2B : WS_W2;
  const int e = it / 768; int r = it % 768;
  if (r < 256) { transpose_job_tile(p.in[29] + ((size_t)(layer * NE + e)) * 2048 * 512, 512, 0, 512, 2048, (bf16*)(ws + W13) + (size_t)e * 1024 * 2048, 0, true, nullptr, r, lds); return; } r -= 256;
  if (r < 256) { transpose_job_tile(p.in[30] + ((size_t)(layer * NE + e)) * 2048 * 512, 512, 0, 512, 2048, (bf16*)(ws + W13) + (size_t)e * 1024 * 2048, 16, true, nullptr, r, lds); return; } r -= 256;
  transpose_job_tile(p.in[31] + ((size_t)(layer * NE + e)) * 512 * 2048, 2048, 0, 2048, 512, (bf16*)(ws + W2) + (size_t)e * 2048 * 512, 0, false, nullptr, r, lds);
}
DEVI bool fill_step(const Params& p, char* lds, FillState& f) {
  if (f.pos >= f.end) {
    if (!f.active) return false;
    int* ctr = (int*)(p.ws + WS_CTL) + CT_WQ + 48; int* slot = (int*)(lds + LDS_BYTES - 32);
    __syncthreads();
    if (threadIdx.x == 0) *slot = atomicAdd(ctr, 16);
    __syncthreads();
    f.pos = *slot + (gridDim.x - 128) * 16; f.end = f.pos + 16;
    if (f.pos >= 2 * TJ_MOE) { f.active = false; f.end = f.pos; return false; }
  }
  moe_tile(p, f.pos, lds);
  ++f.pos;
  return true;
}

DEVI void pack_small(const Params& p, int vb, int G) {
  unsigned char* ws = p.ws;
  bf16* g0 = (bf16*)(ws + WS_WPK);
  bf16* r0 = (bf16*)(ws + WS_WPK + 131072);
  bf16* r1 = (bf16*)(ws + WS_WPK + 131072 + 196608);
  const int total = 64 * 2 * 64 + 2 * 64 * 3 * 64;
  for (int i = vb * NTHR + threadIdx.x; i < total; i += G * NTHR) {
    float v[8];
    bf16* dst;
    if (i < 64 * 2 * 64) {
      const int lane = i & 63, nb = (i >> 6) & 1, ks = i >> 7;
      const int n = 16 * nb + (lane & 15), k0 = 32 * ks + 8 * (lane >> 4);
      const int col = n < 8 ? 3072 + n : (n < 24 ? 6152 + (n - 8) : -1);
#pragma unroll
      for (int j = 0; j < 8; ++j) v[j] = col >= 0 ? p.in[3][(size_t)(k0 + j) * 6168 + col] : 0.f;
      dst = g0 + (size_t)i * 8;
    } else {
      int q = i - 64 * 2 * 64;
      const int layer = q / (64 * 3 * 64); q %= (64 * 3 * 64);
      const int lane = q & 63, nb = (q >> 6) % 3, ks = q / 192;
      const int n = 16 * nb + (lane & 15), k0 = 32 * ks + 8 * (lane >> 4);
#pragma unroll
      for (int j = 0; j < 8; ++j) {
        float x = 0.f;
        if (n < 4) x = p.in[25][((size_t)layer * 2048 + k0 + j) * 4 + n];
        else if (n < 36) x = p.in[27][((size_t)layer * 2048 + k0 + j) * 32 + (n - 4)];
        v[j] = x;
      }
      dst = (layer ? r1 : r0) + (size_t)q * 8;
    }
    u32x4 o; o.x = pk2(v[0], v[1]); o.y = pk2(v[2], v[3]); o.z = pk2(v[4], v[5]); o.w = pk2(v[6], v[7]);
    *(u32x4*)dst = o;
  }
}

DEVI void moe_offsets(const int* cnt, int* lds_off  , int* lds_tp  , int* lds_cnt  , int* lds_map = nullptr  ) {
  if (threadIdx.x < 64) {
    const int lane = threadIdx.x;
    const int c = lane < NE ? cnt[lane * CSTR] : 0;
    const int t = (c + 127) >> 7;
    int o = c, tt = t;
#pragma unroll
    for (int d = 1; d < 32; d <<= 1) { const int o2 = __shfl_up(o, d), t2 = __shfl_up(tt, d); if (lane >= d) { o += o2; tt += t2; } }
    if (lane < NE) {
      lds_off[lane] = o - c; lds_tp[lane] = tt - t; lds_cnt[lane] = c;
      if (lds_map) for (int m = tt - t; m < tt; ++m) lds_map[m] = lane;
    }
    if (lane == NE - 1) { lds_off[NE] = o; lds_tp[NE] = tt; }
  }
  __syncthreads();
}

template <int MODE, int SMALL>
DEVI void rowpass(const Params& p, const float* __restrict__ gain, float* __restrict__ rstd_out, const bf16* __restrict__ wpk, int layer, int vb, int G, char* lds) {
  constexpr int NBK = SMALL == 1 ? 2 : (SMALL == 2 ? 3 : 0);
  constexpr int NA = NBK > 0 ? NBK : 1;
  unsigned char* ws = p.ws;
  bf16* hbuf = (bf16*)(ws + WS_H);
  bf16* xn = (bf16*)(ws + WS_XN);
  const bf16* ymoe = (const bf16*)(ws + WS_YMOE);
  int* ctl = (int*)(ws + WS_CTL);
  int* toke = (int*)(ws + WS_TOKE);
  const int tid = threadIdx.x, lane = tid & 63, wid = tid >> 6;
  float* part = (float*)lds;
  float* lgs = (float*)(lds + 24576);
  float* ssp = (float*)(lds + 29696);
  int* ioff = (int*)(lds + 30208);
  int* itp = ioff + 40; int* icnt = itp + 40;
  if (MODE == 1) moe_offsets(ctl + CT_CNT + layer * NE * CSTR, ioff, itp, icnt);
  for (int it = vb; it < NTOK / 32; it += G) {
    const int kb = 512 * wid + 8 * (lane >> 4);
    const float* src[2]; const bf16* hsrc[2]; const bf16* y0[2]; const bf16* y1[2]; int rowf[2];
#pragma unroll
    for (int f = 0; f < 2; ++f) {
      const int row = 32 * it + 16 * f + (lane & 15);
      rowf[f] = row;
      if (MODE == 0) { const int b = row / T, t = row - b * T; src[f] = t < NMETA ? p.in[1] + (size_t)t * D : p.in[0] + ((size_t)b * SEQ + (t - NMETA)) * D; }
      else src[f] = nullptr;
      hsrc[f] = hbuf + (size_t)row * D;
      y0[f] = nullptr; y1[f] = nullptr;
      if (MODE == 1) {
        const int e0 = toke[row * 4 + 0], e1 = toke[row * 4 + 1], r0 = toke[row * 4 + 2], r1 = toke[row * 4 + 3];
        y0[f] = ymoe + (size_t)(ioff[e0] + r0) * D; y1[f] = ymoe + (size_t)(ioff[e1] + r1) * D;
      }
    }
    f32x4 acc[2][NA];
#pragma unroll
    for (int f = 0; f < 2; ++f)
#pragma unroll
      for (int n = 0; n < NA; ++n) acc[f][n] = (f32x4){0.f, 0.f, 0.f, 0.f};
    float ss[2] = {0.f, 0.f};
    if (SMALL == 2 && tid < 32) ((int*)(lds + 30720))[tid] = 0;
    constexpr int RB = 4;
#pragma unroll 1
    for (int sb = 0; sb < 16; sb += RB) {
      u32x4 ld[RB][2][3]; f32x4 gq0[RB], gq1[RB]; u32x4 wq[RB][NA];
#pragma unroll
      for (int u = 0; u < RB; ++u) {
        const int k = kb + 32 * (sb + u);
#pragma unroll
        for (int f = 0; f < 2; ++f) {
          if (MODE == 0) { ld[u][f][0] = *(const u32x4*)(src[f] + k); ld[u][f][1] = *(const u32x4*)(src[f] + k + 4); }
          else ld[u][f][0] = *(const u32x4*)(hsrc[f] + k);
          if (MODE == 1) { ld[u][f][1] = *(const u32x4*)(y0[f] + k); ld[u][f][2] = *(const u32x4*)(y1[f] + k); }
        }
        gq0[u] = *(const f32x4*)(gain + k); gq1[u] = *(const f32x4*)(gain + k + 4);
        if (NBK > 0) {
          const int ks = 16 * wid + sb + u;
#pragma unroll
          for (int n = 0; n < NBK; ++n) wq[u][n] = *(const u32x4*)(wpk + ((size_t)(ks * NBK + n) * 64 + lane) * 8);
        }
      }
      __builtin_amdgcn_sched_barrier(0);
#pragma unroll
      for (int u = 0; u < RB; ++u) {
        const int k = kb + 32 * (sb + u);
        const f32x4 g0 = gq0[u], g1 = gq1[u];
        bf16x8 xf[2];
#pragma unroll
        for (int f = 0; f < 2; ++f) {
          f32x4 a, b;
          if (MODE == 0) { a = __builtin_bit_cast(f32x4, ld[u][f][0]); b = __builtin_bit_cast(f32x4, ld[u][f][1]); }
          else { const u32x4 hu = ld[u][f][0];
            a[0] = bflo(hu.x); a[1] = bfhi(hu.x); a[2] = bflo(hu.y); a[3] = bfhi(hu.y); b[0] = bflo(hu.z); b[1] = bfhi(hu.z); b[2] = bflo(hu.w); b[3] = bfhi(hu.w); }
          if (MODE == 1) {
            const u32x4 u0 = ld[u][f][1], u1 = ld[u][f][2];
            a[0] += bflo(u0.x) + bflo(u1.x); a[1] += bfhi(u0.x) + bfhi(u1.x); a[2] += bflo(u0.y) + bflo(u1.y); a[3] += bfhi(u0.y) + bfhi(u1.y);
            b[0] += bflo(u0.z) + bflo(u1.z); b[1] += bfhi(u0.z) + bfhi(u1.z); b[2] += bflo(u0.w) + bflo(u1.w); b[3] += bfhi(u0.w) + bfhi(u1.w);
          }
          if (MODE != 2) {
            u32x4 hw; hw.x = pk2(a[0], a[1]); hw.y = pk2(a[2], a[3]); hw.z = pk2(b[0], b[1]); hw.w = pk2(b[2], b[3]);
            *(u32x4*)(hbuf + (size_t)rowf[f] * D + k) = hw;
            a[0] = bflo(hw.x); a[1] = bfhi(hw.x); a[2] = bflo(hw.y); a[3] = bfhi(hw.y); b[0] = bflo(hw.z); b[1] = bfhi(hw.z); b[2] = bflo(hw.w); b[3] = bfhi(hw.w);
          }
          ss[f] += (a[0] * a[0] + a[1] * a[1]) + (a[2] * a[2] + a[3] * a[3]) + (b[0] * b[0] + b[1] * b[1]) + (b[2] * b[2] + b[3] * b[3]);
          u32x4 o; o.x = pk2(a[0] * g0[0], a[1] * g0[1]); o.y = pk2(a[2] * g0[2], a[3] * g0[3]); o.z = pk2(b[0] * g1[0], b[1] * g1[1]); o.w = pk2(b[2] * g1[2], b[3] * g1[3]);
          *(u32x4*)(xn + (size_t)rowf[f] * D + k) = o;
          xf[f] = u4_as_b8(o);
        }
        if (NBK > 0) {
#pragma unroll
          for (int n = 0; n < NBK; ++n) {
            const bf16x8 wf = u4_as_b8(wq[u][n]);
#pragma unroll
            for (int f = 0; f < 2; ++f) acc[f][n] = mfma16(wf, xf[f], acc[f][n]);
          }
        }
      }
      __builtin_amdgcn_sched_barrier(0);
    }
#pragma unroll
    for (int f = 0; f < 2; ++f) {
      float v = ss[f]; v += __shfl_xor(v, 16); v += __shfl_xor(v, 32);
      if (lane < 16) ssp[wid * 32 + 16 * f + lane] = v;
      if (NBK > 0) {
#pragma unroll
        for (int n = 0; n < NBK; ++n) *(f32x4*)(part + (wid * 32 + 16 * f + (lane & 15)) * 48 + 16 * n + 4 * (lane >> 4)) = acc[f][n];
      }
    }
    __syncthreads();
    if (tid < 32) {
      const float tot = (ssp[tid] + ssp[32 + tid]) + (ssp[64 + tid] + ssp[96 + tid]);
      const float rs = rsqrtf(tot * (1.f / D) + EPS);
      rstd_out[32 * it + tid] = rs;
      if (SMALL == 2) {
        float* lg = lgs + tid * 40;
        for (int c = 0; c < 36; ++c) {
          const float sacc = (part[(0 * 32 + tid) * 48 + c] + part[(1 * 32 + tid) * 48 + c]) + (part[(2 * 32 + tid) * 48 + c] + part[(3 * 32 + tid) * 48 + c]);
          lg[c] = rs * sacc + (c < 4 ? p.in[26][layer * 4 + c] : p.in[28][layer * 32 + (c - 4)]);
        }
        int grp = 0; float gm = lg[0];
#pragma unroll
        for (int c = 1; c < 4; ++c) if (lg[c] > gm) { gm = lg[c]; grp = c; }
        float gs = 0.f;
#pragma unroll
        for (int c = 0; c < 4; ++c) gs += __expf(lg[c] - gm);
        const float ptop = 1.f / gs;
        float el[8];
#pragma unroll
        for (int j = 0; j < 8; ++j) el[j] = lg[4 + grp * 8 + j];
        int i0 = 0; float m0 = el[0];
#pragma unroll
        for (int j = 1; j < 8; ++j) if (el[j] > m0) { m0 = el[j]; i0 = j; }
        int i1 = -1; float m1 = -3.0e38f;
#pragma unroll
        for (int j = 0; j < 8; ++j) if (j != i0 && el[j] > m1) { m1 = el[j]; i1 = j; }
        const float w0 = 1.f / (1.f + __expf(m1 - m0)), w1 = 1.f - w0;
        const int e0 = grp * 8 + i0, e1 = grp * 8 + i1;
        const int trow = 32 * it + tid;
        int* cnt = ctl + CT_CNT + layer * NE * CSTR;
        int* lcnt = (int*)(lds + 30720); int* lbase = lcnt + 32;
        const int l0 = __hip_atomic_fetch_add(lcnt + e0, 1, __ATOMIC_RELAXED, __HIP_MEMORY_SCOPE_WORKGROUP);
        const int l1 = __hip_atomic_fetch_add(lcnt + e1, 1, __ATOMIC_RELAXED, __HIP_MEMORY_SCOPE_WORKGROUP);
        __builtin_amdgcn_fence(__ATOMIC_SEQ_CST, "workgroup");
        const int nloc = ((volatile int*)lcnt)[tid];
        int gb = 0;
        if (nloc > 0) gb = atomicAdd(cnt + tid * CSTR, nloc);
        ((volatile int*)lbase)[tid] = gb;
        __builtin_amdgcn_fence(__ATOMIC_SEQ_CST, "workgroup");
        const int r0 = ((volatile int*)lbase)[e0] + l0, r1 = ((volatile int*)lbase)[e1] + l1;
        int* list = (int*)(ws + WS_LIST); float* glist = (float*)(ws + WS_GLIST);
        list[e0 * NTOK + r0] = trow; glist[e0 * NTOK + r0] = ptop * w0;
        list[e1 * NTOK + r1] = trow; glist[e1 * NTOK + r1] = ptop * w1;
        toke[trow * 4 + 0] = e0; toke[trow * 4 + 1] = e1; toke[trow * 4 + 2] = r0; toke[trow * 4 + 3] = r1;
      }
    }
    if (SMALL == 1) {
      float* gates = (float*)(ws + WS_GATES);
      for (int q = tid; q < 32 * 24; q += NTHR) {
        const int r = q / 24, c = q % 24;
        const float tot = (ssp[r] + ssp[32 + r]) + (ssp[64 + r] + ssp[96 + r]);
        const float rs = rsqrtf(tot * (1.f / D) + EPS);
        const float sacc = (part[(0 * 32 + r) * 48 + c] + part[(1 * 32 + r) * 48 + c]) + (part[(2 * 32 + r) * 48 + c] + part[(3 * 32 + r) * 48 + c]);
        gates[(size_t)(32 * it + r) * 32 + c] = rs * sacc;
      }
    }
    __syncthreads();
  }
}

template <int MODE, int SMALL>
DEVI void rowpass2(const Params& p, const float* __restrict__ gain, float* __restrict__ rstd_out, const bf16* __restrict__ wpk, int layer, int bx, int G, char* lds) {
  constexpr int NBK = SMALL == 1 ? 2 : 3;
  constexpr int XS = 2176;
  constexpr int NL = MODE == 0 ? 2 : 1;
  unsigned char* ws = p.ws;
  bf16* hbuf = (bf16*)(ws + WS_H);
  bf16* xn = (bf16*)(ws + WS_XN);
  int* ctl = (int*)(ws + WS_CTL);
  int* toke = (int*)(ws + WS_TOKE);
  const int tid = threadIdx.x, lane = tid & 63, wid = tid >> 6;
  float* part = (float*)lds;
  float* rsl = (float*)(lds + 69632);
  float* lgs = (float*)(lds + 69760);
  int* lcnt = (int*)(lds + 74880); int* lbase = lcnt + 32;
  for (int it = bx; it < NTOK / 32; it += G) {
    if (SMALL == 2 && tid < 32) lcnt[tid] = 0;
    f32x4 acc[2][NBK];
#pragma unroll
    for (int f = 0; f < 2; ++f)
#pragma unroll
      for (int n = 0; n < NBK; ++n) acc[f][n] = (f32x4){0.f, 0.f, 0.f, 0.f};
    float ssr[8];
#pragma unroll
    for (int rr = 0; rr < 8; ++rr) ssr[rr] = 0.f;
#pragma unroll 1
    for (int half = 0; half < 2; ++half) {
      const int cb = 1024 * half + 8 * lane;
      f32x4 g[2][2];
#pragma unroll
      for (int j = 0; j < 2; ++j) { g[j][0] = *(const f32x4*)(gain + cb + 512 * j); g[j][1] = *(const f32x4*)(gain + cb + 512 * j + 4); }
      constexpr int RQ = MODE == 0 ? 4 : 8;
#pragma unroll
      for (int rb = 0; rb < 8; rb += RQ) {
        u32x4 ld[RQ][2][NL];
#pragma unroll
        for (int rq = 0; rq < RQ; ++rq) {
          const int row = 32 * it + 8 * wid + rb + rq;
          if (MODE == 0) {
            const int b = row / T, t = row - b * T;
            const float* sp = t < NMETA ? p.in[1] + (size_t)t * D : p.in[0] + ((size_t)b * SEQ + (t - NMETA)) * D;
#pragma unroll
            for (int j = 0; j < 2; ++j) { ld[rq][j][0] = *(const u32x4*)(sp + cb + 512 * j); ld[rq][j][NL - 1] = *(const u32x4*)(sp + cb + 512 * j + 4); }
          } else {
#pragma unroll
            for (int j = 0; j < 2; ++j) ld[rq][j][0] = *(const u32x4*)(hbuf + (size_t)row * D + cb + 512 * j);
          }
        }
        __builtin_amdgcn_sched_barrier(0);
#pragma unroll
        for (int rq = 0; rq < RQ; ++rq) {
          const int rr = rb + rq, R = 8 * wid + rr, row = 32 * it + R;
#pragma unroll
          for (int j = 0; j < 2; ++j) {
            f32x4 a, b;
            if (MODE == 0) { a = __builtin_bit_cast(f32x4, ld[rq][j][0]); b = __builtin_bit_cast(f32x4, ld[rq][j][NL - 1]);
              u32x4 hw; hw.x = pk2(a[0], a[1]); hw.y = pk2(a[2], a[3]); hw.z = pk2(b[0], b[1]); hw.w = pk2(b[2], b[3]);
              *(u32x4*)(hbuf + (size_t)row * D + cb + 512 * j) = hw;
              a[0] = bflo(hw.x); a[1] = bfhi(hw.x); a[2] = bflo(hw.y); a[3] = bfhi(hw.y); b[0] = bflo(hw.z); b[1] = bfhi(hw.z); b[2] = bflo(hw.w); b[3] = bfhi(hw.w);
            } else { const u32x4 hu = ld[rq][j][0];
              a[0] = bflo(hu.x); a[1] = bfhi(hu.x); a[2] = bflo(hu.y); a[3] = bfhi(hu.y); b[0] = bflo(hu.z); b[1] = bfhi(hu.z); b[2] = bflo(hu.w); b[3] = bfhi(hu.w); }
            ssr[rr] += (a[0] * a[0] + a[1] * a[1]) + (a[2] * a[2] + a[3] * a[3]) + (b[0] * b[0] + b[1] * b[1]) + (b[2] * b[2] + b[3] * b[3]);
            const f32x4 g0 = g[j][0], g1 = g[j][1];
            u32x4 o; o.x = pk2(a[0] * g0[0], a[1] * g0[1]); o.y = pk2(a[2] * g0[2], a[3] * g0[3]); o.z = pk2(b[0] * g1[0], b[1] * g1[1]); o.w = pk2(b[2] * g1[2], b[3] * g1[3]);
            *(u32x4*)(xn + (size_t)row * D + cb + 512 * j) = o;
            const int ktile = (lane >> 3) + 8 * j, c = lane & 7;
            *(u32x4*)(lds + R * XS + ktile * 128 + ((c ^ ((R >> 1) & 7)) << 4)) = o;
          }
        }
        __builtin_amdgcn_sched_barrier(0);
      }
      u32x4 wq[8][NBK];
#pragma unroll
      for (int s = 0; s < 8; ++s) {
        const int ks = 32 * half + 8 * wid + s;
#pragma unroll
        for (int n = 0; n < NBK; ++n) wq[s][n] = *(const u32x4*)(wpk + ((size_t)(ks * NBK + n) * 64 + lane) * 8);
      }
      __syncthreads();
#pragma unroll
      for (int s = 0; s < 8; ++s) {
        const int ktile = 4 * wid + (s >> 1), c = 4 * (s & 1) + (lane >> 4);
        bf16x8 xf[2];
#pragma unroll
        for (int f = 0; f < 2; ++f) { const int R = 16 * f + (lane & 15); xf[f] = *(const bf16x8*)(lds + R * XS + ktile * 128 + ((c ^ ((R >> 1) & 7)) << 4)); }
#pragma unroll
        for (int n = 0; n < NBK; ++n) {
          const bf16x8 wf = u4_as_b8(wq[s][n]);
#pragma unroll
          for (int f = 0; f < 2; ++f) acc[f][n] = mfma16(wf, xf[f], acc[f][n]);
        }
      }
      __syncthreads();
    }
    {
      float mine = 0.f;
#pragma unroll
      for (int rr = 0; rr < 8; ++rr) {
        float v = ssr[rr];
#pragma unroll
        for (int d = 1; d < 64; d <<= 1) v += __shfl_xor(v, d);
        if (lane == rr) mine = v;
      }
      if (lane < 8) { const float rs = rsqrtf(mine * (1.f / D) + EPS); rsl[8 * wid + lane] = rs; rstd_out[32 * it + 8 * wid + lane] = rs; }
    }
#pragma unroll
    for (int f = 0; f < 2; ++f)
#pragma unroll
      for (int n = 0; n < NBK; ++n) *(f32x4*)(part + (wid * 32 + 16 * f + (lane & 15)) * 48 + 16 * n + 4 * (lane >> 4)) = acc[f][n];
    __syncthreads();
    if (SMALL == 2 && tid < 32) {
      const float rs = rsl[tid];
      float* lg = lgs + tid * 40;
      for (int c = 0; c < 36; ++c) {
        const float sacc = (part[(0 * 32 + tid) * 48 + c] + part[(1 * 32 + tid) * 48 + c]) + (part[(2 * 32 + tid) * 48 + c] + part[(3 * 32 + tid) * 48 + c]);
        lg[c] = rs * sacc + (c < 4 ? p.in[26][layer * 4 + c] : p.in[28][layer * 32 + (c - 4)]);
      }
      int grp = 0; float gm = lg[0];
#pragma unroll
      for (int c = 1; c < 4; ++c) if (lg[c] > gm) { gm = lg[c]; grp = c; }
      float gs = 0.f;
#pragma unroll
      for (int c = 0; c < 4; ++c) gs += __expf(lg[c] - gm);
      const float ptop = 1.f / gs;
      float el[8];
#pragma unroll
      for (int j = 0; j < 8; ++j) el[j] = lg[4 + grp * 8 + j];
      int i0 = 0; float m0 = el[0];
#pragma unroll
      for (int j = 1; j < 8; ++j) if (el[j] > m0) { m0 = el[j]; i0 = j; }
      int i1 = -1; float m1 = -3.0e38f;
#pragma unroll
      for (int j = 0; j < 8; ++j) if (j != i0 && el[j] > m1) { m1 = el[j]; i1 = j; }
      const float w0 = 1.f / (1.f + __expf(m1 - m0)), w1 = 1.f - w0;
      const int e0 = grp * 8 + i0, e1 = grp * 8 + i1;
      const int trow = 32 * it + tid;
      int* cnt = ctl + CT_CNT + layer * NE * CSTR;
      const int l0 = __hip_atomic_fetch_add(lcnt + e0, 1, __ATOMIC_RELAXED, __HIP_MEMORY_SCOPE_WORKGROUP);
      const int l1 = __hip_atomic_fetch_add(lcnt + e1, 1, __ATOMIC_RELAXED, __HIP_MEMORY_SCOPE_WORKGROUP);
      __builtin_amdgcn_fence(__ATOMIC_SEQ_CST, "workgroup");
      const int nloc = ((volatile int*)lcnt)[tid];
      int gb = 0;
      if (nloc > 0) gb = atomicAdd(cnt + tid * CSTR, nloc);
      ((volatile int*)lbase)[tid] = gb;
      __builtin_amdgcn_fence(__ATOMIC_SEQ_CST, "workgroup");
      const int r0 = ((volatile int*)lbase)[e0] + l0, r1 = ((volatile int*)lbase)[e1] + l1;
      int* list = (int*)(ws + WS_LIST); float* glist = (float*)(ws + WS_GLIST);
      list[e0 * NTOK + r0] = trow; glist[e0 * NTOK + r0] = ptop * w0;
      list[e1 * NTOK + r1] = trow; glist[e1 * NTOK + r1] = ptop * w1;
      toke[trow * 4 + 0] = e0; toke[trow * 4 + 1] = e1; toke[trow * 4 + 2] = r0; toke[trow * 4 + 3] = r1;
    }
    if (SMALL == 1) {
      float* gates = (float*)(ws + WS_GATES);
      for (int q = tid; q < 32 * 24; q += NTHR) {
        const int r = q / 24, c = q % 24;
        const float sacc = (part[(0 * 32 + r) * 48 + c] + part[(1 * 32 + r) * 48 + c]) + (part[(2 * 32 + r) * 48 + c] + part[(3 * 32 + r) * 48 + c]);
        gates[(size_t)(32 * it + r) * 32 + c] = rsl[r] * sacc;
      }
    }
    __syncthreads();
  }
}

DEVI void combine_norm(const Params& p, const float* __restrict__ gain, float* __restrict__ rstd_out, int layer, int bx, int G, char* lds) {
  unsigned char* ws = p.ws;
  bf16* hbuf = (bf16*)(ws + WS_H); bf16* xn = (bf16*)(ws + WS_XN);
  const bf16* ymoe = (const bf16*)(ws + WS_YMOE);
  const int* toke = (const int*)(ws + WS_TOKE);
  int* ioff = (int*)lds; int* itp = ioff + 40; int* icnt = itp + 40;
  moe_offsets((const int*)(ws + WS_CTL) + CT_CNT + layer * NE * CSTR, ioff, itp, icnt);
  const int lane = threadIdx.x & 63, wid = threadIdx.x >> 6;
  f32x4 g[4][2];
#pragma unroll
  for (int j = 0; j < 4; ++j) { g[j][0] = *(const f32x4*)(gain + 8 * lane + 512 * j); g[j][1] = *(const f32x4*)(gain + 8 * lane + 512 * j + 4); }
  const int W = G * 4;
  for (int r0 = bx * 4 + wid; r0 < NTOK; r0 += 2 * W) {
    u32x4 hv[2][4], ya[2][4], yb[2][4];
#pragma unroll
    for (int q = 0; q < 2; ++q) {
      int row = r0 + q * W; row = row < NTOK ? row : r0;
      const int e0 = toke[row * 4 + 0], e1 = toke[row * 4 + 1], s0 = toke[row * 4 + 2], s1 = toke[row * 4 + 3];
      const bf16* y0 = ymoe + (size_t)(ioff[e0] + s0) * D; const bf16* y1 = ymoe + (size_t)(ioff[e1] + s1) * D;
      const bf16* hs = hbuf + (size_t)row * D;
#pragma unroll
      for (int j = 0; j < 4; ++j) { const int k = 8 * lane + 512 * j; hv[q][j] = *(const u32x4*)(hs + k); ya[q][j] = *(const u32x4*)(y0 + k); yb[q][j] = *(const u32x4*)(y1 + k); }
    }
    __builtin_amdgcn_sched_barrier(0);
#pragma unroll
    for (int q = 0; q < 2; ++q) {
      const int row = r0 + q * W;
      if (row < NTOK) {
        float ss = 0.f;
#pragma unroll
        for (int j = 0; j < 4; ++j) {
          const int k = 8 * lane + 512 * j;
          const u32x4 hu = hv[q][j], u0 = ya[q][j], u1 = yb[q][j];
          f32x4 a, b;
          a[0] = bflo(hu.x); a[1] = bfhi(hu.x); a[2] = bflo(hu.y); a[3] = bfhi(hu.y); b[0] = bflo(hu.z); b[1] = bfhi(hu.z); b[2] = bflo(hu.w); b[3] = bfhi(hu.w);
          a[0] += bflo(u0.x) + bflo(u1.x); a[1] += bfhi(u0.x) + bfhi(u1.x); a[2] += bflo(u0.y) + bflo(u1.y); a[3] += bfhi(u0.y) + bfhi(u1.y);
          b[0] += bflo(u0.z) + bflo(u1.z); b[1] += bfhi(u0.z) + bfhi(u1.z); b[2] += bflo(u0.w) + bflo(u1.w); b[3] += bfhi(u0.w) + bfhi(u1.w);
          u32x4 hw; hw.x = pk2(a[0], a[1]); hw.y = pk2(a[2], a[3]); hw.z = pk2(b[0], b[1]); hw.w = pk2(b[2], b[3]);
          *(u32x4*)(hbuf + (size_t)row * D + k) = hw;
          a[0] = bflo(hw.x); a[1] = bfhi(hw.x); a[2] = bflo(hw.y); a[3] = bfhi(hw.y); b[0] = bflo(hw.z); b[1] = bfhi(hw.z); b[2] = bflo(hw.w); b[3] = bfhi(hw.w);
          ss += (a[0] * a[0] + a[1] * a[1]) + (a[2] * a[2] + a[3] * a[3]) + (b[0] * b[0] + b[1] * b[1]) + (b[2] * b[2] + b[3] * b[3]);
          const f32x4 g0 = g[j][0], g1 = g[j][1];
          u32x4 o; o.x = pk2(a[0] * g0[0], a[1] * g0[1]); o.y = pk2(a[2] * g0[2], a[3] * g0[3]); o.z = pk2(b[0] * g1[0], b[1] * g1[1]); o.w = pk2(b[2] * g1[2], b[3] * g1[3]);
          *(u32x4*)(xn + (size_t)row * D + k) = o;
        }
#pragma unroll
        for (int d = 1; d < 64; d <<= 1) ss += __shfl_xor(ss, d);
        if (lane == 0) rstd_out[row] = rsqrtf(ss * (1.f / D) + EPS);
      }
    }
  }
}

DEVI void final_combine(const Params& p, int vb, int G, char* lds) {
  unsigned char* ws = p.ws;
  const bf16* hbuf = (const bf16*)(ws + WS_H);
  const bf16* ymoe = (const bf16*)(ws + WS_YMOE);
  const int* toke = (const int*)(ws + WS_TOKE);
  int* ioff = (int*)lds; int* itp = ioff + 40; int* icnt = itp + 40;
  moe_offsets((const int*)(ws + WS_CTL) + CT_CNT + NE * CSTR, ioff, itp, icnt);
  const int lane = threadIdx.x & 63, wid = threadIdx.x >> 6;
  const int W = G * 4;
  for (int r0 = vb * 4 + wid; r0 < NB * SEQ; r0 += 2 * W) {
    u32x4 hv[2][4], ya[2][4], yb[2][4];
#pragma unroll
    for (int q = 0; q < 2; ++q) {
      int r = r0 + q * W; r = r < NB * SEQ ? r : r0;
      const int b = r / SEQ, s = r - b * SEQ, row = b * T + NMETA + s;
      const int e0 = toke[row * 4 + 0], e1 = toke[row * 4 + 1], s0 = toke[row * 4 + 2], s1 = toke[row * 4 + 3];
      const bf16* y0 = ymoe + (size_t)(ioff[e0] + s0) * D; const bf16* y1 = ymoe + (size_t)(ioff[e1] + s1) * D;
      const bf16* hs = hbuf + (size_t)row * D;
#pragma unroll
      for (int j = 0; j < 4; ++j) { const int k = 8 * lane + 512 * j; hv[q][j] = *(const u32x4*)(hs + k); ya[q][j] = *(const u32x4*)(y0 + k); yb[q][j] = *(const u32x4*)(y1 + k); }
    }
    __builtin_amdgcn_sched_barrier(0);
#pragma unroll
    for (int q = 0; q < 2; ++q) {
      const int r = r0 + q * W;
      if (r < NB * SEQ) {
        float* o = p.out + (size_t)r * D;
#pragma unroll
        for (int j = 0; j < 4; ++j) {
          const int k = 8 * lane + 512 * j;
          const u32x4 hu = hv[q][j], u0 = ya[q][j], u1 = yb[q][j];
          f32x4 a, c; a[0] = bflo(hu.x); a[1] = bfhi(hu.x); a[2] = bflo(hu.y); a[3] = bfhi(hu.y); c[0] = bflo(hu.z); c[1] = bfhi(hu.z); c[2] = bflo(hu.w); c[3] = bfhi(hu.w);
          a[0] += bflo(u0.x) + bflo(u1.x); a[1] += bfhi(u0.x) + bfhi(u1.x); a[2] += bflo(u0.y) + bflo(u1.y); a[3] += bfhi(u0.y) + bfhi(u1.y);
          c[0] += bflo(u0.z) + bflo(u1.z); c[1] += bfhi(u0.z) + bfhi(u1.z); c[2] += bflo(u0.w) + bflo(u1.w); c[3] += bfhi(u0.w) + bfhi(u1.w);
          *(f32x4*)(o + k) = a; *(f32x4*)(o + k + 4) = c;
        }
      }
    }
  }
}

template <class Epi, int VAR = 0>
DEVI void gemm_tile(const bf16* __restrict__ A, int lda, const int* __restrict__ rows, int nvalid, int arow0,
                    const bf16* __restrict__ Bt, int ldb, int K, char* lds, const Epi& epi) {
  const int tid = threadIdx.x, lane = tid & 63, wid = tid >> 6, wm = wid >> 1, wn = wid & 1;
  const int srow = tid >> 3, sch = tid & 7;
  const bf16* ap[4]; const bf16* bp[4]; unsigned sw[4];
#pragma unroll
  for (int i = 0; i < 4; ++i) {
    const int r = srow + 32 * i;
    int gr;
    if (rows) { const int rr = r < nvalid ? r : 0; gr = rows[rr]; } else gr = arow0 + r;
    ap[i] = A + (size_t)gr * lda + sch * 8;
    bp[i] = Bt + (size_t)r * ldb + sch * 8;
    sw[i] = (unsigned)(r * 128 + ((sch ^ ((r >> 1) & 7)) << 4));
  }
  u32x4 ra0[4], rb0[4], ra1[4], rb1[4];
  f32x4 acc[4][4];
#pragma unroll
  for (int i = 0; i < 4; ++i)
#pragma unroll
    for (int j = 0; j < 4; ++j) acc[i][j] = (f32x4){0.f, 0.f, 0.f, 0.f};
  const int arl = wm * 64 + (lane & 15), brl = wn * 64 + (lane & 15);
  const int swa = (arl >> 1) & 7, swb = (brl >> 1) & 7;
  const int nk = K >> 6;
#define G_LOAD(RA, RB, kt_) do { if (VAR != 3 && VAR < 5) { _Pragma("unroll") for (int i = 0; i < 4; ++i) { RA[i] = *(const u32x4*)(ap[i] + (kt_) * 64); RB[i] = *(const u32x4*)(bp[i] + (kt_) * 64); } } } while (0)
#define G_STORE(RA, RB, buf_) do { if (VAR == 7) break; char* nb_ = lds + (buf_) * 32768; _Pragma("unroll") for (int i = 0; i < 4; ++i) { *(u32x4*)(nb_ + sw[i]) = RA[i]; *(u32x4*)(nb_ + 16384 + sw[i]) = RB[i]; } } while (0)
#define G_COMPUTE(buf_) do { if (VAR == 2) break; const char* base = lds + (buf_) * 32768; \
    bf16x8 af[2][4], bfr[2][4]; \
    _Pragma("unroll") for (int kk = 0; kk < 2; ++kk) { const int c = 4 * kk + (lane >> 4); \
      if (VAR >= 6) { _Pragma("unroll") for (int i = 0; i < 4; ++i) { af[kk][i] = u4_as_b8(ra0[i]); bfr[kk][i] = u4_as_b8(rb1[i]); asm volatile("" : "+v"(af[kk][i]), "+v"(bfr[kk][i])); } } else { \
      _Pragma("unroll") for (int i = 0; i < 4; ++i) af[kk][i] = *(const bf16x8*)(base + (arl + 16 * i) * 128 + ((c ^ swa) << 4)); \
      _Pragma("unroll") for (int j = 0; j < 4; ++j) bfr[kk][j] = *(const bf16x8*)(base + 16384 + (brl + 16 * j) * 128 + ((c ^ swb) << 4)); } } \
    _Pragma("unroll") for (int kk = 0; kk < 2; ++kk) { \
      if (VAR == 1 || VAR == 5) { _Pragma("unroll") for (int i = 0; i < 4; ++i) { asm volatile("" :: "v"(af[kk][i]), "v"(bfr[kk][i])); } } \
      else { _Pragma("unroll") for (int i = 0; i < 4; ++i) _Pragma("unroll") for (int j = 0; j < 4; ++j) acc[i][j] = mfma16(bfr[kk][j], af[kk][i], acc[i][j]); } } } while (0)
  if (VAR == 3 || VAR >= 5) { _Pragma("unroll") for (int i = 0; i < 4; ++i) { ra0[i] = (u32x4){1u,2u,3u,4u}; rb0[i] = ra0[i]; ra1[i] = ra0[i]; rb1[i] = ra0[i]; } }
  G_LOAD(ra0, rb0, 0);
  G_LOAD(ra1, rb1, 1);
  G_STORE(ra0, rb0, 0);
  if (VAR != 4) __syncthreads();
  for (int kt = 0; kt < nk; kt += 2) {
    const int k2 = kt + 2 < nk ? kt + 2 : nk - 1, k3 = kt + 3 < nk ? kt + 3 : nk - 1;
    G_LOAD(ra0, rb0, k2);
    __builtin_amdgcn_sched_barrier(0);
    G_COMPUTE(0);
    G_STORE(ra1, rb1, 1);
    if (VAR != 4) __syncthreads();
    G_LOAD(ra1, rb1, k3);
    __builtin_amdgcn_sched_barrier(0);
    G_COMPUTE(1);
    G_STORE(ra0, rb0, 0);
    if (VAR != 4) __syncthreads();
  }
#undef G_LOAD
#undef G_STORE
#undef G_COMPUTE
  epi(acc, wm, wn, lane);
}

DEVI void tile_of(int L, int MT, int NT, int& pm, int& pn) {
  const int nig = 8 * NT, gid = L / nig, fm = gid * 8, gsz = (MT - fm) < 8 ? (MT - fm) : 8;
  const int w = L - gid * nig;
  pm = fm + (w % gsz); pn = w / gsz;
}

struct TileDesc { const bf16* A; int lda; const int* rows; int nvalid; int arow0; const bf16* Bt; int ldb; int K; };
template <class Src>
DEVI void gemm_loop(const Src& src, int first, int stride, int count, char* lds) {
  const int nfull = count / stride, remt = count - nfull * stride;
  const int tl = stride == 512 ? ((((first & 63) >> 3) * 8 + (first >> 6)) * 8 + (first & 7)) : first;
  const int nmy = nfull + (tl < remt ? 1 : 0);
  if (nmy == 0) return;
#define GL_TILE_AT(r_) ((r_) < nfull ? first + (r_) * stride : nfull * stride + tl)
  const int tid = threadIdx.x, lane = tid & 63, wid = tid >> 6, wm = wid >> 1, wn = wid & 1;
  const int srow = tid >> 3, sch = (tid & 7) ^ ((tid >> 4) & 7);
  const int arl = wm * 64 + (lane & 15), brl = wn * 64 + (lane & 15);
  const int swa = (arl >> 1) & 7, swb = (brl >> 1) & 7;
  const bf16* ap[4]; const bf16* bp[4]; const bf16* apn[4]; const bf16* bpn[4];
#define GL_SETUP(AP, BP, d_) do { _Pragma("unroll") for (int i = 0; i < 4; ++i) { const int r = srow + 32 * i; int gr; \
      if ((d_).rows) { const int rr = r < (d_).nvalid ? r : 0; gr = (d_).rows[rr]; } else gr = (d_).arow0 + r; \
      AP[i] = (d_).A + (size_t)gr * (d_).lda + sch * 8; BP[i] = (d_).Bt + (size_t)r * (d_).ldb + sch * 8; } } while (0)
#define GL_DMA(AP, BP, koff_, buf_) do { _Pragma("unroll") for (int i = 0; i < 4; ++i) { \
      __builtin_amdgcn_global_load_lds((const unsigned*)(AP[i] + (koff_)), (LAS unsigned*)(lds + (buf_) * 32768 + i * 4096 + wid * 1024), 16, 0, 0); \
      __builtin_amdgcn_global_load_lds((const unsigned*)(BP[i] + (koff_)), (LAS unsigned*)(lds + (buf_) * 32768 + 16384 + i * 4096 + wid * 1024), 16, 0, 0); } } while (0)
#define GL_COMPUTE(buf_) do { const char* base = lds + (buf_) * 32768; \
    _Pragma("unroll") for (int kk = 0; kk < 2; ++kk) { const int c = 4 * kk + (lane >> 4); bf16x8 af[4], bfr[4]; \
      _Pragma("unroll") for (int i = 0; i < 4; ++i) af[i] = *(const bf16x8*)(base + (arl + 16 * i) * 128 + ((c ^ swa) << 4)); \
      _Pragma("unroll") for (int j = 0; j < 4; ++j) bfr[j] = *(const bf16x8*)(base + 16384 + (brl + 16 * j) * 128 + ((c ^ swb) << 4)); \
      __builtin_amdgcn_s_setprio(1); \
      _Pragma("unroll") for (int i = 0; i < 4; ++i) _Pragma("unroll") for (int j = 0; j < 4; ++j) acc[i][j] = mfma16(bfr[j], af[i], acc[i][j]); \
      __builtin_amdgcn_s_setprio(0); } } while (0)
#define GL_WAITSYNC() do { asm volatile("s_waitcnt vmcnt(0)" ::: "memory"); __syncthreads(); } while (0)
#define GL_STEP(AP, BP, koff_, rbuf_, wbuf_) do { const char* base = lds + (rbuf_) * 32768; \
    GL_DMA(AP, BP, koff_, wbuf_); \
    __builtin_amdgcn_sched_barrier(0); \
    bf16x8 af0[4], bq0[4], af1[4], bq1[4]; \
    { const int c = (lane >> 4); \
      _Pragma("unroll") for (int i = 0; i < 4; ++i) af0[i] = *(const bf16x8*)(base + (arl + 16 * i) * 128 + ((c ^ swa) << 4)); \
      _Pragma("unroll") for (int j = 0; j < 4; ++j) bq0[j] = *(const bf16x8*)(base + 16384 + (brl + 16 * j) * 128 + ((c ^ swb) << 4)); } \
    __builtin_amdgcn_sched_barrier(0); \
    { const int c = 4 + (lane >> 4); \
      _Pragma("unroll") for (int i = 0; i < 4; ++i) af1[i] = *(const bf16x8*)(base + (arl + 16 * i) * 128 + ((c ^ swa) << 4)); \
      _Pragma("unroll") for (int j = 0; j < 4; ++j) bq1[j] = *(const bf16x8*)(base + 16384 + (brl + 16 * j) * 128 + ((c ^ swb) << 4)); } \
    __builtin_amdgcn_sched_barrier(0); \
    __builtin_amdgcn_s_setprio(1); \
    _Pragma("unroll") for (int i = 0; i < 4; ++i) { \
      acc[i][0] = mfma16(bq0[0], af0[i], acc[i][0]); acc[i][1] = mfma16(bq0[1], af0[i], acc[i][1]); \
      acc[i][2] = mfma16(bq0[2], af0[i], acc[i][2]); acc[i][3] = mfma16(bq0[3], af0[i], acc[i][3]); } \
    _Pragma("unroll") for (int i = 0; i < 4; ++i) _Pragma("unroll") for (int j = 0; j < 4; ++j) acc[i][j] = mfma16(bq1[j], af1[i], acc[i][j]); \
    __builtin_amdgcn_s_setprio(0); } while (0)
  f32x4 acc[4][4];
  TileDesc d; src.tile(GL_TILE_AT(0), d);
  GL_SETUP(ap, bp, d);
  int nk = d.K >> 6;
  GL_DMA(ap, bp, 0, 0);
  GL_WAITSYNC();
  for (int rnd = 0; rnd < nmy; ++rnd) {
    const int idx = GL_TILE_AT(rnd);
    const int nidx = rnd + 1 < nmy ? GL_TILE_AT(rnd + 1) : idx;
    TileDesc dn; src.tile(nidx, dn);
    GL_SETUP(apn, bpn, dn);
#pragma unroll
    for (int i = 0; i < 4; ++i)
#pragma unroll
      for (int j = 0; j < 4; ++j) acc[i][j] = (f32x4){0.f, 0.f, 0.f, 0.f};
#pragma unroll 1
    for (int kt = 0; kt < nk; kt += 2) {
      GL_STEP(ap, bp, (kt + 1) * 64, 0, 1);
      GL_WAITSYNC();
      {
        const bool last = kt + 2 >= nk;
        const bf16* pa[4]; const bf16* pb[4];
#pragma unroll
        for (int i = 0; i < 4; ++i) { pa[i] = last ? apn[i] : ap[i] + (kt + 2) * 64; pb[i] = last ? bpn[i] : bp[i] + (kt + 2) * 64; }
        GL_STEP(pa, pb, 0, 1, 0);
      }
      GL_WAITSYNC();
    }
    src.epilogue(idx, acc, wm, wn, lane);
#pragma unroll
    for (int i = 0; i < 4; ++i) { ap[i] = apn[i]; bp[i] = bpn[i]; }
    nk = dn.K >> 6;
  }
#undef GL_SETUP
#undef GL_DMA
#undef GL_COMPUTE
#undef GL_STEP
#undef GL_WAITSYNC
#undef GL_TILE_AT
}

template <class Src>
DEVI void gemm_loop_half(const Src& src, int first, int stride, int count, char* lds) {
  if (first >= count) return;
  const int tid = threadIdx.x, lane = tid & 63, wid = tid >> 6;
  const int srow = tid >> 3, sch = (tid & 7) ^ ((tid >> 4) & 7);
  const int arl = wid * 32 + (lane & 15), brl = (lane & 15);
  const int swa = (arl >> 1) & 7, swb = (brl >> 1) & 7;
  const bf16* ap[4]; const bf16* bp[2]; const bf16* apn[4]; const bf16* bpn[2];
#define GH_SETUP(AP, BP, d_) do { _Pragma("unroll") for (int i = 0; i < 4; ++i) { const int r = srow + 32 * i; int gr; \
      if ((d_).rows) { const int rr = r < (d_).nvalid ? r : 0; gr = (d_).rows[rr]; } else gr = (d_).arow0 + r; \
      AP[i] = (d_).A + (size_t)gr * (d_).lda + sch * 8; if (i < 2) BP[i] = (d_).Bt + (size_t)r * (d_).ldb + sch * 8; } } while (0)
#define GH_DMA(AP, BP, koff_, buf_) do { _Pragma("unroll") for (int i = 0; i < 4; ++i) { \
      __builtin_amdgcn_global_load_lds((const unsigned*)(AP[i] + (koff_)), (LAS unsigned*)(lds + (buf_) * 32768 + i * 4096 + wid * 1024), 16, 0, 0); \
      if (i < 2) __builtin_amdgcn_global_load_lds((const unsigned*)(BP[i] + (koff_)), (LAS unsigned*)(lds + (buf_) * 32768 + 16384 + i * 4096 + wid * 1024), 16, 0, 0); } } while (0)
#define GH_COMPUTE(buf_) do { const char* base = lds + (buf_) * 32768; \
    bf16x8 af0[2], bq0[4], af1[2], bq1[4];     \
    { const int c = (lane >> 4); \
      _Pragma("unroll") for (int i = 0; i < 2; ++i) af0[i] = *(const bf16x8*)(base + (arl + 16 * i) * 128 + ((c ^ swa) << 4)); \
      _Pragma("unroll") for (int j = 0; j < 4; ++j) bq0[j] = *(const bf16x8*)(base + 16384 + (brl + 16 * j) * 128 + ((c ^ swb) << 4)); } \
    { const int c = 4 + (lane >> 4); \
      _Pragma("unroll") for (int i = 0; i < 2; ++i) af1[i] = *(const bf16x8*)(base + (arl + 16 * i) * 128 + ((c ^ swa) << 4)); \
      _Pragma("unroll") for (int j = 0; j < 4; ++j) bq1[j] = *(const bf16x8*)(base + 16384 + (brl + 16 * j) * 128 + ((c ^ swb) << 4)); } \
    __builtin_amdgcn_sched_barrier(0); \
    __builtin_amdgcn_s_setprio(1); \
    _Pragma("unroll") for (int i = 0; i < 2; ++i) _Pragma("unroll") for (int j = 0; j < 4; ++j) acc[i][j] = mfma16(bq0[j], af0[i], acc[i][j]); \
    _Pragma("unroll") for (int i = 0; i < 2; ++i) _Pragma("unroll") for (int j = 0; j < 4; ++j) acc[i][j] = mfma16(bq1[j], af1[i], acc[i][j]); \
    __builtin_amdgcn_s_setprio(0); } while (0)
#define GH_WAITSYNC() do { asm volatile("s_waitcnt vmcnt(0)" ::: "memory"); __syncthreads(); } while (0)
  f32x4 acc[2][4];
  TileDesc d; src.tile(first, d);
  GH_SETUP(ap, bp, d);
  int nk = d.K >> 6;
  GH_DMA(ap, bp, 0, 0);
  GH_WAITSYNC();
  for (int idx = first; idx < count; idx += stride) {
    const int nidx = idx + stride < count ? idx + stride : idx;
    TileDesc dn; src.tile(nidx, dn);
    GH_SETUP(apn, bpn, dn);
#pragma unroll
    for (int i = 0; i < 2; ++i)
#pragma unroll
      for (int j = 0; j < 4; ++j) acc[i][j] = (f32x4){0.f, 0.f, 0.f, 0.f};
#pragma unroll 1
    for (int kt = 0; kt < nk; kt += 2) {
      GH_DMA(ap, bp, (kt + 1) * 64, 1);
      GH_COMPUTE(0);
      GH_WAITSYNC();
      {
        const bool last = kt + 2 >= nk;
        const bf16* pa[4]; const bf16* pb[2];
#pragma unroll
        for (int i = 0; i < 4; ++i) { pa[i] = last ? apn[i] : ap[i] + (kt + 2) * 64; if (i < 2) pb[i] = last ? bpn[i] : bp[i] + (kt + 2) * 64; }
        GH_DMA(pa, pb, 0, 0);
      }
      GH_COMPUTE(1);
      GH_WAITSYNC();
    }
    src.epilogue_half(idx, acc, wid, lane);
#pragma unroll
    for (int i = 0; i < 4; ++i) { ap[i] = apn[i]; if (i < 2) bp[i] = bpn[i]; }
    nk = dn.K >> 6;
  }
#undef GH_SETUP
#undef GH_DMA
#undef GH_COMPUTE
#undef GH_WAITSYNC
}

DEVI void wide_pair(const f32x4& a, const f32x4& b, float s, u32x4& w) {
  const unsigned ax = pk2(a[0] * s, a[1] * s), ay = pk2(a[2] * s, a[3] * s), bx = pk2(b[0] * s, b[1] * s), by = pk2(b[2] * s, b[3] * s);
  const auto sx = __builtin_amdgcn_permlane16_swap(ax, bx, false, false);
  const auto sy = __builtin_amdgcn_permlane16_swap(ay, by, false, false);
  w.x = sx[0]; w.y = sy[0]; w.z = sx[1]; w.w = sy[1];
}
struct EpiBf16 {
  bf16* out; int ldo; const float* rs; int m0, n0, mvalid;
  DEVI void operator()(const f32x4 (&acc)[4][4], int wm, int wn, int lane) const {
    float sv[4];
#pragma unroll
    for (int i = 0; i < 4; ++i) { const int row = m0 + wm * 64 + 16 * i + (lane & 15); sv[i] = rs ? rs[row < mvalid ? row : mvalid - 1] : 1.f; }
#pragma unroll
    for (int i = 0; i < 4; ++i) {
      const int row = m0 + wm * 64 + 16 * i + (lane & 15);
      if (row < mvalid) {
        const float s = sv[i];
#pragma unroll
        for (int jp = 0; jp < 4; jp += 2) {
          u32x4 w; wide_pair(acc[i][jp], acc[i][jp + 1], s, w);
          const int g = lane >> 4, col = n0 + wn * 64 + 16 * (jp + (g & 1)) + 4 * (g & 2);
          *(u32x4*)(out + (size_t)row * ldo + col) = w;
        }
      }
    }
  }
};
struct EpiResid {
  bf16* h; int m0, n0;
  DEVI void operator()(const f32x4 (&acc)[4][4], int wm, int wn, int lane) const {
    const int g = lane >> 4;
    u32x4 hv[4][2];
#pragma unroll
    for (int i = 0; i < 4; ++i) {
      const int row = m0 + wm * 64 + 16 * i + (lane & 15), rc = row < NTOK ? row : NTOK - 1;
#pragma unroll
      for (int q = 0; q < 2; ++q) hv[i][q] = *(const u32x4*)(h + (size_t)rc * D + n0 + wn * 64 + 16 * (2 * q + (g & 1)) + 4 * (g & 2));
    }
#pragma unroll
    for (int i = 0; i < 4; ++i) {
      const int row = m0 + wm * 64 + 16 * i + (lane & 15);
#pragma unroll
      for (int q = 0; q < 2; ++q) {
        float lo[4], hi[4];
#pragma unroll
        for (int r = 0; r < 4; ++r) {
          const auto sw = __builtin_amdgcn_permlane16_swap(__float_as_uint(acc[i][2 * q][r]), __float_as_uint(acc[i][2 * q + 1][r]), false, false);
          lo[r] = __uint_as_float(sw[0]); hi[r] = __uint_as_float(sw[1]);
        }
        if (row < NTOK) {
          const u32x4 hu = hv[i][q];
          u32x4 o; o.x = pk2(bflo(hu.x) + lo[0], bfhi(hu.x) + lo[1]); o.y = pk2(bflo(hu.y) + lo[2], bfhi(hu.y) + lo[3]);
          o.z = pk2(bflo(hu.z) + hi[0], bfhi(hu.z) + hi[1]); o.w = pk2(bflo(hu.w) + hi[2], bfhi(hu.w) + hi[3]);
          *(u32x4*)(h + (size_t)row * D + n0 + wn * 64 + 16 * (2 * q + (g & 1)) + 4 * (g & 2)) = o;
        }
      }
    }
  }
};
struct EpiResidAtomic {
  float* h; int m0, n0;
  DEVI void operator()(const f32x4 (&acc)[4][4], int wm, int wn, int lane) const {
#pragma unroll
    for (int i = 0; i < 4; ++i) {
      const int row = m0 + wm * 64 + 16 * i + (lane & 15);
      if (row < NTOK) {
#pragma unroll
        for (int j = 0; j < 4; ++j) {
          const int col = n0 + wn * 64 + 16 * j + 4 * (lane >> 4);
          float* d = h + (size_t)row * D + col;
#pragma unroll
          for (int r = 0; r < 4; ++r) __hip_atomic_fetch_add(d + r, acc[i][j][r], __ATOMIC_RELAXED, __HIP_MEMORY_SCOPE_AGENT);
        }
      }
    }
  }
};
struct EpiSplitZ {
  float* zt; int n0; int ld;
  DEVI void operator()(const f32x4 (&acc)[4][4], int wm, int wn, int lane) const {
    if (wm == 0) {
#pragma unroll
      for (int i = 0; i < 4; ++i) {
        const int rl = 16 * i + (lane & 15);
#pragma unroll
        for (int j = 0; j < 1; ++j) {
          float* dptr = zt + (size_t)rl * ld + n0 + wn * 64 + 4 * (lane >> 4);
          asm volatile("global_store_dwordx4 %0, %1, off sc0 sc1\n\tglobal_store_dwordx4 %0, %2, off offset:64 sc0 sc1\n\tglobal_store_dwordx4 %0, %3, off offset:128 sc0 sc1\n\tglobal_store_dwordx4 %0, %4, off offset:192 sc0 sc1\n\ts_nop 1"
                       :: "v"(dptr), "v"(acc[i][0]), "v"(acc[i][1]), "v"(acc[i][2]), "v"(acc[i][3]) : "memory");
        }
      }
    }
  }
};
struct EpiMoe1 {
  bf16* hb; const int* rows; const float* rs; int cnt, slot0, c0;
  DEVI void operator()(const f32x4 (&acc)[4][4], int wm, int wn, int lane) const {
    float sv[4];
#pragma unroll
    for (int i = 0; i < 4; ++i) { const int rl = wm * 64 + 16 * i + (lane & 15); sv[i] = rs[rows[rl < cnt ? rl : cnt - 1]]; }
#pragma unroll
    for (int i = 0; i < 4; ++i) {
      const int rl = wm * 64 + 16 * i + (lane & 15);
      if (rl < cnt) {
        const float s = sv[i];
        f32x4 v0, v1;
#pragma unroll
        for (int r = 0; r < 4; ++r) { v0[r] = siluf_(acc[i][0][r] * s) * (acc[i][1][r] * s); v1[r] = siluf_(acc[i][2][r] * s) * (acc[i][3][r] * s); }
        u32x4 w; wide_pair(v0, v1, 1.f, w);
        const int g = lane >> 4, col = c0 + wn * 32 + 16 * (g & 1) + 4 * (g & 2);
        *(u32x4*)(hb + (size_t)(slot0 + rl) * 512 + col) = w;
      }
    }
  }
};
struct EpiMoe2 {
  bf16* y; const float* gl; int cnt, slot0, n0;
  DEVI void operator()(const f32x4 (&acc)[4][4], int wm, int wn, int lane) const {
    float sv[4];
#pragma unroll
    for (int i = 0; i < 4; ++i) { const int rl = wm * 64 + 16 * i + (lane & 15); sv[i] = gl[rl < cnt ? rl : cnt - 1]; }
#pragma unroll
    for (int i = 0; i < 4; ++i) {
      const int rl = wm * 64 + 16 * i + (lane & 15);
      if (rl < cnt) {
        const float s = sv[i];
#pragma unroll
        for (int jp = 0; jp < 4; jp += 2) {
          u32x4 w; wide_pair(acc[i][jp], acc[i][jp + 1], s, w);
          const int g = lane >> 4, col = n0 + wn * 64 + 16 * (jp + (g & 1)) + 4 * (g & 2);
          *(u32x4*)(y + (size_t)(slot0 + rl) * D + col) = w;
        }
      }
    }
  }
};

template <class MakeEpi>
struct DenseSrc {
  const bf16* A; int lda; const bf16* Bt; int K, MT, NT; const MakeEpi& mk;
  DEVI void tile(int L, TileDesc& d) const { int pm, pn; tile_of(L, MT, NT, pm, pn); d.A = A; d.lda = lda; d.rows = nullptr; d.nvalid = 128; d.arow0 = pm * 128; d.Bt = Bt + (size_t)pn * 128 * K; d.ldb = K; d.K = K; }
  DEVI void epilogue(int L, const f32x4 (&acc)[4][4], int wm, int wn, int lane) const { int pm, pn; tile_of(L, MT, NT, pm, pn); auto e = mk(pm * 128, pn * 128); e(acc, wm, wn, lane); }
};
template <class MakeEpi>
DEVI void gemm_phase(const bf16* A, int lda, const bf16* Bt, int K, int N, int vb, int G, char* lds, const MakeEpi& mk, int flags = 0) {
  DenseSrc<MakeEpi> src{A, lda, Bt, K, MPAD / 128, N / 128, mk};
  gemm_loop(src, vb, G, (MPAD / 128) * (N / 128), lds);
}
DEVI void outproj_phase(const bf16* A, const bf16* Bt, bf16* h, unsigned char* ws, int layer, int vb, int G, char* lds) {
  {
    auto mk = [&](int m0, int n0) { return EpiResid{h, m0, n0}; };
    DenseSrc<decltype(mk)> src{A, D, Bt, 2048, 64, 16, mk};
    gemm_loop(src, vb, G, 64 * 16, lds);
  }
  {
    float* slabs = (float*)(ws + WS_ZT);
    int* tickets = (int*)(ws + WS_CTL) + CT_SPLITZ + 64 + layer * 16;
    int* flag = (int*)(lds + 65536);
    const int npc = G == 512 ? ((vb & 63) < 16 ? 1 : 0) : (vb < 128 ? (128 - vb + G - 1) / G : 0);
    for (int q = 0; q < npc; ++q) {
      const int it = G == 512 ? ((((vb & 63) >> 3) * 8 + (vb >> 6)) * 8 + (vb & 7)) : vb + q * G;
      const int pn = it >> 3, ks = it & 7;
      EpiSplitZ epi{slabs + (size_t)ks * 64 * 2048, pn * 128, 2048};
      gemm_tile(A + ks * 256, D, nullptr, 128, 64 * 128, Bt + (size_t)pn * 128 * 2048 + ks * 256, 2048, 256, lds, epi);
      asm volatile("s_waitcnt vmcnt(0)" ::: "memory");
      __syncthreads();
      if (threadIdx.x == 0) {
        asm volatile("s_waitcnt vmcnt(0)" ::: "memory");
        const int t = __hip_atomic_fetch_add(tickets + pn, 1, __ATOMIC_RELAXED, __HIP_MEMORY_SCOPE_AGENT);
        if (t == 7) { __builtin_amdgcn_fence(__ATOMIC_ACQUIRE, "agent"); asm volatile("s_waitcnt vmcnt(0)" ::: "memory"); }
        *flag = (t == 7);
      }
      __syncthreads();
      if (*flag) {
        const int tid = threadIdx.x;
#pragma unroll
        for (int i = 0; i < 8; ++i) {
          const int idx = tid + 256 * i, rl = idx >> 5, c4 = (idx & 31) * 4;
          f32x4 v = *(const f32x4*)(slabs + (size_t)rl * 2048 + pn * 128 + c4);
#pragma unroll
          for (int q = 1; q < 8; ++q) v += *(const f32x4*)(slabs + (size_t)q * 64 * 2048 + (size_t)rl * 2048 + pn * 128 + c4);
          bf16* d = h + (size_t)(8192 + rl) * D + pn * 128 + c4;
          const u32x2 hu = *(const u32x2*)d;
          u32x2 o; o.x = pk2(bflo(hu.x) + v[0], bfhi(hu.x) + v[1]); o.y = pk2(bflo(hu.y) + v[2], bfhi(hu.y) + v[3]);
          *(u32x2*)d = o;
        }
      }
      __syncthreads();
    }
  }
}

DEVI void inproj0_phase(const Params& p, int vb, int G, char* lds) {
  unsigned char* ws = p.ws;
  const bf16* A = (const bf16*)(ws + WS_XN); const bf16* Bt = (const bf16*)(ws + WS_WIN0);
  bf16* Z = (bf16*)(ws + WS_Z); const float* rstd = (const float*)(ws + WS_RSTD);
  float* zt = (float*)(ws + WS_ZT);
  int* tickets = (int*)(ws + WS_CTL) + CT_SPLITZ;
  {
    auto mk = [&](int m0, int n0) { return EpiBf16{Z, ZLD0, rstd, m0, n0, NTOK}; };
    DenseSrc<decltype(mk)> src{A, D, Bt, 2048, 64, 48, mk};
    gemm_loop(src, vb, G, 64 * 48, lds);
  }
  int* flag = (int*)(lds + 65536);
  for (int it = vb; it < 48 * 8; it += G) {
    const int pn = it >> 3, ks = it & 7;
    EpiSplitZ epi{zt + (size_t)ks * 64 * 6144, pn * 128, 6144};
    gemm_tile(A + ks * 256, D, nullptr, 128, 64 * 128, Bt + (size_t)pn * 128 * 2048 + ks * 256, 2048, 256, lds, epi);
    asm volatile("s_waitcnt vmcnt(0)" ::: "memory");
    __syncthreads();
    if (threadIdx.x == 0) {
      asm volatile("s_waitcnt vmcnt(0)" ::: "memory");
      const int t = __hip_atomic_fetch_add(tickets + pn, 1, __ATOMIC_RELAXED, __HIP_MEMORY_SCOPE_AGENT);
      if (t == 7) { __builtin_amdgcn_fence(__ATOMIC_ACQUIRE, "agent"); asm volatile("s_waitcnt vmcnt(0)" ::: "memory"); }
      *flag = (t == 7);
    }
    __syncthreads();
    if (*flag) {
      const int tid = threadIdx.x;
#pragma unroll
      for (int i = 0; i < 8; ++i) {
        const int idx = tid + 256 * i, rl = idx >> 5, c4 = (idx & 31) * 4;
        f32x4 v = *(const f32x4*)(zt + (size_t)rl * 6144 + pn * 128 + c4);
#pragma unroll
        for (int q = 1; q < 8; ++q) v += *(const f32x4*)(zt + (size_t)q * 64 * 6144 + (size_t)rl * 6144 + pn * 128 + c4);
        const float sc = rstd[8192 + rl];
        u32x2 o; o.x = pk2(v[0] * sc, v[1] * sc); o.y = pk2(v[2] * sc, v[3] * sc);
        *(u32x2*)(Z + (size_t)(8192 + rl) * ZLD0 + pn * 128 + c4) = o;
      }
    }
    __syncthreads();
  }
}

constexpr int SQ = 0, SK = 16384, SV = 32768, SPM = 43008, SCT = 51200, SSC = 72704;

DEVI int qoff(int row, int dk) { return row * 256 + ((((dk >> 3) ^ (row & 15))) << 4) + (dk & 7) * 2; }

DEVI void scan_S(const char* lds, int wid, int lane, bf16x8 (&aq)[4], f32x4 (&accS)[4]) {
  const int l15 = lane & 15, g = lane >> 4;
#pragma unroll
  for (int j = 0; j < 4; ++j) accS[j] = (f32x4){0.f, 0.f, 0.f, 0.f};
#pragma unroll
  for (int ks = 0; ks < 4; ++ks) {
    const int c = 4 * ks + g;
    aq[ks] = *(const bf16x8*)(lds + SQ + (16 * wid + l15) * 256 + ((c ^ l15) << 4));
#pragma unroll
    for (int j = 0; j < 4; ++j) {
      const bf16x8 bk = *(const bf16x8*)(lds + SK + (16 * j + l15) * 256 + ((c ^ l15) << 4));
      accS[j] = mfma16(bk, aq[ks], accS[j]);
    }
  }
}
DEVI void scan_PM_write(char* lds, int wid, int lane, int j, const float (&v)[4]) {
  const int t = 16 * wid + (lane & 15), g = lane >> 4;
  const int cidx = 2 * j + (g >> 1);
  u32x2 o; o.x = pk2(v[0], v[1]); o.y = pk2(v[2], v[3]);
  *(u32x2*)(lds + SPM + t * 128 + ((cidx ^ ((t >> 1) & 7)) << 4) + 8 * (g & 1)) = o;
}
DEVI bf16x8 scan_Vfrag(const char* lds, int lane, int ks, int j) {
  const int g = lane >> 4, q = (lane & 15) >> 2, pp = lane & 3;
  const char* a0 = lds + SV + (32 * ks + 8 * g + q) * 160 + (16 * j + 4 * pp) * 2;
  return cat4(lds_tr16(a0), lds_tr16(a0 + 4 * 160));
}
DEVI bf16x8 scan_KTfrag(const char* lds, int lane, int ks, int dkb) {
  const int g = lane >> 4, q = (lane & 15) >> 2, pp = lane & 3;
  const int r0 = 32 * ks + 8 * g + q, r1 = r0 + 4;
  const int ch = (dkb >> 3) + (pp >> 1);
  const char* a0 = lds + SK + r0 * 256 + ((ch ^ (r0 & 15)) << 4) + 8 * (pp & 1);
  const char* a1 = lds + SK + r1 * 256 + ((ch ^ (r1 & 15)) << 4) + 8 * (pp & 1);
  return cat4(lds_tr16(a0), lds_tr16(a1));
}
template <int NBV>
DEVI void scan_PV(const char* lds, int wid, int lane, f32x4 (&accO)[NBV]) {
  const int t = 16 * wid + (lane & 15), g = lane >> 4;
#pragma unroll
  for (int ks = 0; ks < 2; ++ks) {
    const bf16x8 ap = *(const bf16x8*)(lds + SPM + t * 128 + (((4 * ks + g) ^ ((t >> 1) & 7)) << 4));
#pragma unroll
    for (int j = 0; j < NBV; ++j) accO[j] = mfma16(scan_Vfrag(lds, lane, ks, j), ap, accO[j]);
  }
}
template <int NBV>
DEVI void scan_QC(const char* lds, int lane, const bf16x8 (&aq)[4], f32x4 (&accO)[NBV]) {
  const int g = lane >> 4, q = (lane & 15) >> 2, pp = lane & 3;
#pragma unroll
  for (int ks = 0; ks < 4; ++ks) {
    const char* r0 = lds + SCT + (32 * ks + 8 * g + q) * 168 + 8 * pp;
#pragma unroll
    for (int j = 0; j < NBV; ++j) {
      const bf16x8 bc = cat4(lds_tr16(r0 + 32 * j), lds_tr16(r0 + 4 * 168 + 32 * j));
      accO[j] = mfma16(bc, aq[ks], accO[j]);
    }
  }
}
template <int NBV>
DEVI void scan_CT_write(char* lds, int wid, int lane, const f32x4 (&st)[2][NBV], float sc0, float sc1) {
  const int g = lane >> 4;
#pragma unroll
  for (int i = 0; i < 2; ++i) {
    const int dk = 32 * wid + 16 * i + (lane & 15);
    const float sc = i ? sc1 : sc0;
#pragma unroll
    for (int j = 0; j < NBV; ++j) {
      u32x2 o; o.x = pk2(st[i][j][0] * sc, st[i][j][1] * sc); o.y = pk2(st[i][j][2] * sc, st[i][j][3] * sc);
      *(u32x2*)(lds + SCT + dk * 168 + (16 * j + 4 * g) * 2) = o;
    }
  }
}

DEVI void prep_copy_out(const char* lds, unsigned char* dstimg) {
  __syncthreads();
  const int tid = threadIdx.x;
#pragma unroll
  for (int i = 0; i < 8; ++i) *(u32x4*)(dstimg + (size_t)(tid + 256 * i) * 16) = *(const u32x4*)(lds + (tid + 256 * i) * 16);
  __syncthreads();
}
DEVI void mlstm_prep(const Params& p, int item, char* lds) {
  unsigned char* ws = p.ws;
  const bf16* Z = (const bf16*)(ws + WS_Z);
  const int tid = threadIdx.x;
  const int c = item % 33, bh = item / 33, b = bh >> 2, h = bh & 3;
  const int L = c == 0 ? 16 : 64, t0 = c == 0 ? 0 : 16 + 64 * (c - 1), HL = L >> 1;
  const int row0 = b * T + t0;
  const int dk = tid & 127, hh = tid >> 7;
  const int cq = h * 128 + dk, ck = 512 + cq;
  float wq[4], wk[4];
#pragma unroll
  for (int j = 0; j < 4; ++j) { wq[j] = p.in[4][j * 1024 + cq]; wk[j] = p.in[4][j * 1024 + ck]; }
  const float bq = p.in[5][cq], bk = p.in[5][ck];
  const int ts = hh * HL;
  float xq[35], xk[35];
  {
    const int rbase = row0 + ts - 3, rmin = b * T;
#pragma unroll
    for (int i = 0; i < 35; ++i) {
      int r = rbase + i; r = r < rmin ? rmin : r;
      const bf16* zr = Z + (size_t)r * ZLD0;
      xq[i] = bf2f(zr[cq]); xk[i] = bf2f(zr[ck]);
    }
    const int tl0 = t0 + ts - 3;
#pragma unroll
    for (int i = 0; i < 3; ++i) if (tl0 + i < 0) { xq[i] = 0.f; xk[i] = 0.f; }
  }
#pragma unroll
  for (int i = 0; i < 32; ++i) {
    if (i < HL) {
      const int t = ts + i;
      const float aq_ = bq + wq[0] * xq[i] + wq[1] * xq[i + 1] + wq[2] * xq[i + 2] + wq[3] * xq[i + 3];
      const float ak_ = bk + wk[0] * xk[i] + wk[1] * xk[i + 1] + wk[2] * xk[i + 2] + wk[3] * xk[i + 3];
      *(bf16*)(lds + SQ + qoff(t, dk)) = (bf16)f2bf(siluf_(aq_));
      *(bf16*)(lds + SK + qoff(t, dk)) = (bf16)f2bf(siluf_(ak_) * 0.08838834764831845f);
    }
  }
  if (L < 64) {
    const int rem = (64 - L) >> 1;
    for (int i = 0; i < rem; ++i) { const int t = L + hh * rem + i; *(bf16*)(lds + SQ + qoff(t, dk)) = 0; *(bf16*)(lds + SK + qoff(t, dk)) = 0; }
  }
  prep_copy_out(lds, ws + WS_PQK + (size_t)item * 32768);
}
template <bool HG>
DEVI void gla_prep(const Params& p, int item, char* lds) {
  unsigned char* ws = p.ws;
  const bf16* Z = (const bf16*)(ws + WS_Z);
  const float* gates = (const float*)(ws + WS_GATES);
  constexpr int ZLD = HG ? ZLD1 : ZLD0;
  const int tid = threadIdx.x;
  const int c = item % 33, bh = item / 33;
  const int b = HG ? (bh >> 3) : (bh >> 2), h = HG ? (bh & 7) : (bh & 3);
  const int L = c == 0 ? 16 : 64, t0 = c == 0 ? 0 : 16 + 64 * (c - 1), HL = L >> 1;
  const int row0 = b * T + t0;
  float* sc = (float*)(lds + SSC);
  float* TOT0 = sc; float* TOT1 = sc + 128; float* FIRST1 = sc + 256; float* BA = sc + 768;
  const int dk = tid & 127, hh = tid >> 7;
  const int ch = h * 128 + dk;
  const int qcol = HG ? ch : 3072 + ch, kcol = HG ? 1024 + ch : 3584 + ch;
  float wg[16]; float bg = 0.f, lb = 0.f;
  if (!HG) {
#pragma unroll
    for (int r = 0; r < 16; ++r) wg[r] = p.in[9][r * 512 + ch];
    bg = p.in[10][ch];
  } else {
    lb = 1.f / (1.f + __expf(p.in[15][ch] - p.in[15][1024 + ch]));
  }
  if (!HG) {
    const int s = tid >> 2, part = tid & 3;
    f32x4 v = (f32x4){0.f, 0.f, 0.f, 0.f};
    if (s < L) v = *(const f32x4*)(gates + (size_t)(row0 + s) * 32 + 8 + 4 * part);
    *(f32x4*)(BA + s * 16 + 4 * part) = v;
    __syncthreads();
  }
  const int ts = hh * HL;
  float kx[32], qx[32];
#pragma unroll
  for (int i = 0; i < 32; ++i) {
    const bf16* zr = Z + (size_t)(row0 + ts + i) * ZLD;
    kx[i] = bf2f(zr[kcol]); qx[i] = bf2f(zr[qcol]);
  }
  float lgv[32];
  {
    float run = 0.f, first = 0.f;
#pragma unroll
    for (int i = 0; i < 32; ++i) {
      lgv[i] = 0.f;
      if (i < HL) {
        const int t = ts + i;
        float lg;
        if (!HG) {
          float a = bg;
#pragma unroll
          for (int r = 0; r < 4; ++r) { const f32x4 bb = *(const f32x4*)(BA + t * 16 + 4 * r); a += bb[0] * wg[4 * r] + bb[1] * wg[4 * r + 1] + bb[2] * wg[4 * r + 2] + bb[3] * wg[4 * r + 3]; }
          lg = logsigmoidf_(a) * (1.f / 16.f);
        } else {
          const float sg = sigmoidf_(kx[i]);
          lg = __logf(lb + (1.f - lb) * sg);
          kx[i] = (1.f - lb) * (1.f - sg);
        }
        lgv[i] = lg;
        if (i == 0) first = lg;
        run += lg;
      }
    }
    if (hh == 0) TOT0[dk] = run; else { TOT1[dk] = run; FIRST1[dk] = first; }
  }
  __syncthreads();
  {
    const float tot0 = TOT0[dk], gref = tot0 + FIRST1[dk], gend = tot0 + TOT1[dk];
    float run = hh ? tot0 : 0.f;
#pragma unroll
    for (int i = 0; i < 32; ++i) {
      if (i < HL) {
        const int t = ts + i;
        const float lg = lgv[i], kk = kx[i];
        run += lg;
        float q = qx[i];
        if (!HG) q *= 0.08838834764831845f;
        *(bf16*)(lds + SQ + qoff(t, dk)) = (bf16)f2bf(q * __expf(run - gref));
        *(bf16*)(lds + SK + qoff(t, dk)) = (bf16)f2bf(kk * __expf(gref - run));
      }
    }
    if (L < 64) {
      const int rem = (64 - L) >> 1;
      for (int i = 0; i < rem; ++i) { const int t = L + hh * rem + i; *(bf16*)(lds + SQ + qoff(t, dk)) = 0; *(bf16*)(lds + SK + qoff(t, dk)) = 0; }
    }
    const int img = HG ? item : 528 + item;
    if (hh == 0) {
      float* vec = (float*)(ws + WS_PVEC) + (size_t)img * 384;
      vec[dk] = __expf(gref); vec[128 + dk] = __expf(gend - gref); vec[256 + dk] = __expf(gend);
    }
    prep_copy_out(lds, ws + WS_PQK + (size_t)img * 32768);
  }
}

struct ScanPre { u32x4 q[4], k[4], v[2]; };
DEVI void scan_prefetch(ScanPre& pr, const unsigned char* img, const bf16* vsrc  , int zld, int L, int tid) {
#pragma unroll
  for (int i = 0; i < 4; ++i) { pr.q[i] = *(const u32x4*)(img + (size_t)(tid + 256 * i) * 16); pr.k[i] = *(const u32x4*)(img + 16384 + (size_t)(tid + 256 * i) * 16); }
  const int s = tid >> 2, part = tid & 3;
  const int sl = s < L ? s : 0;
  const bf16* src = vsrc + (size_t)sl * zld + 16 * part;
  pr.v[0] = *(const u32x4*)src; pr.v[1] = *(const u32x4*)(src + 8);
  if (s >= L) { pr.v[0] = (u32x4){0u, 0u, 0u, 0u}; pr.v[1] = pr.v[0]; }
}
DEVI void scan_store(const ScanPre& pr, char* lds, int tid) {
#pragma unroll
  for (int i = 0; i < 4; ++i) { *(u32x4*)(lds + SQ + (tid + 256 * i) * 16) = pr.q[i]; *(u32x4*)(lds + SK + (tid + 256 * i) * 16) = pr.k[i]; }
  const int s = tid >> 2, part = tid & 3;
  *(u32x4*)(lds + SV + s * 160 + 32 * part) = pr.v[0]; *(u32x4*)(lds + SV + s * 160 + 32 * part + 16) = pr.v[1];
}

DEVI void mlstm_item(const Params& p, int item, char* lds) {
  unsigned char* ws = p.ws;
  const bf16* Z = (const bf16*)(ws + WS_Z);
  const float* gates = (const float*)(ws + WS_GATES);
  bf16* hraw = (bf16*)(ws + WS_HRAW);
  const int tid = threadIdx.x, lane = tid & 63, wid = tid >> 6;
  const int b = item >> 4, h = (item >> 2) & 3, vs = item & 3;
  float* sc = (float*)(lds + SSC);
  float* Bc = sc; float* U = sc + 64; float* PMx = sc + 128; float* F = sc + 192; float* misc = sc + 256;
  const float b_i = p.in[6][h], b_f = p.in[7][h];
  const unsigned char* img0 = ws + WS_PQK + (size_t)((b * 4 + h) * 33) * 32768;
  const bf16* vbase = Z + (size_t)(b * T) * ZLD0 + 1024 + h * 256 + vs * 64;
  f32x4 st[2][5];
#pragma unroll
  for (int i = 0; i < 2; ++i)
#pragma unroll
    for (int j = 0; j < 5; ++j) st[i][j] = (f32x4){0.f, 0.f, 0.f, 0.f};
  float m = 0.f;
  ScanPre pr; float g_ai, g_af;
  scan_prefetch(pr, img0, vbase, ZLD0, 16, tid);
  { const int r = b * T + (lane < 16 ? lane : 0); g_ai = gates[(size_t)r * 32 + h]; g_af = gates[(size_t)r * 32 + 4 + h]; }
  for (int c = 0; c < 33; ++c) {
    const int L = c == 0 ? 16 : 64, t0 = c == 0 ? 0 : 16 + 64 * (c - 1);
    const int row0 = b * T + t0;
    scan_store(pr, lds, tid);
    {
      const int s = tid >> 2, part = tid & 3;
      if (part == 0) { u32x4 e0 = (u32x4){0u, 0u, 0u, 0u}; if (s < L) e0.x = 0x3F80u; *(u32x4*)(lds + SV + s * 160 + 128) = e0; *(u32x4*)(lds + SV + s * 160 + 144) = (u32x4){0u, 0u, 0u, 0u}; }
    }
    if (wid == 0) {
      const bool valid = lane < L;
      const float ig = valid ? g_ai + b_i : -1e30f, lf = valid ? logsigmoidf_(g_af + b_f) : 0.f;
      float bc = lf;
#pragma unroll
      for (int d = 1; d < 64; d <<= 1) { const float v = __shfl_up(bc, d); if (lane >= d) bc += v; }
      const float u = ig - bc;
      float pmx = u;
#pragma unroll
      for (int d = 1; d < 64; d <<= 1) { const float v = __shfl_up(pmx, d); if (lane >= d) pmx = fmaxf(pmx, v); }
      const float b_end = __shfl(bc, L - 1), umax = __shfl(pmx, L - 1);
      const float m_new = fmaxf(b_end + m, b_end + umax);
      Bc[lane] = bc; U[lane] = u; PMx[lane] = fmaxf(m, pmx);
      F[lane] = valid ? __expf(b_end + u - m_new) : 0.f;
      if (lane == 0) { misc[0] = m_new; misc[1] = __expf(b_end + m - m_new); }
    }
    __syncthreads();
    if (c + 1 < 33) {
      const int t1 = 16 + 64 * c;
      scan_prefetch(pr, img0 + (size_t)(c + 1) * 32768, vbase + (size_t)t1 * ZLD0, ZLD0, 64, tid);
      const int r = b * T + t1 + lane; g_ai = gates[(size_t)r * 32 + h]; g_af = gates[(size_t)r * 32 + 4 + h];
    }
    const float m_new = misc[0], a_st = misc[1];
    scan_CT_write<5>(lds, wid, lane, st, 1.f, 1.f);
    bf16x8 aq[4]; f32x4 accS[4];
    scan_S(lds, wid, lane, aq, accS);
    const int t = 16 * wid + (lane & 15), g = lane >> 4;
    const float pm_t = PMx[t];
#pragma unroll
    for (int j = 0; j < 4; ++j) {
      const f32x4 u4 = *(const f32x4*)(U + 16 * j + 4 * g);
      float v[4];
#pragma unroll
      for (int r = 0; r < 4; ++r) { const int s = 16 * j + 4 * g + r; v[r] = s <= t ? accS[j][r] * __expf(u4[r] - pm_t) : 0.f; }
      scan_PM_write(lds, wid, lane, j, v);
    }
    __syncthreads();
    {
      f32x4 o1[5], o2[5];
#pragma unroll
      for (int j = 0; j < 5; ++j) { o1[j] = (f32x4){0.f, 0.f, 0.f, 0.f}; o2[j] = o1[j]; }
      scan_PV<5>(lds, wid, lane, o1);
      scan_QC<5>(lds, lane, aq, o2);
      const float a_t = __expf(m - pm_t), m_t = Bc[t] + pm_t;
      const float den0 = o1[4][0] + a_t * o2[4][0];
      const float den = __shfl(den0, lane & 15);
      const float inv = 1.f / fmaxf(fabsf(den), __expf(-m_t));
      if (t < L) {
        bf16* dst = hraw + (size_t)(row0 + t) * D + h * 256 + vs * 64 + 4 * g;
#pragma unroll
        for (int j = 0; j < 4; ++j) {
          u32x2 o; o.x = pk2((o1[j][0] + a_t * o2[j][0]) * inv, (o1[j][1] + a_t * o2[j][1]) * inv); o.y = pk2((o1[j][2] + a_t * o2[j][2]) * inv, (o1[j][3] + a_t * o2[j][3]) * inv);
          *(u32x2*)(dst + 16 * j) = o;
        }
      }
    }
#pragma unroll
    for (int i = 0; i < 2; ++i)
#pragma unroll
      for (int j = 0; j < 5; ++j) st[i][j] *= a_st;
#pragma unroll
    for (int ks = 0; ks < 2; ++ks) {
      const f32x4 f0 = *(const f32x4*)(F + 32 * ks + 8 * g), f1 = *(const f32x4*)(F + 32 * ks + 8 * g + 4);
      bf16x8 ak[2];
#pragma unroll
      for (int i = 0; i < 2; ++i) {
        const bf16x8 kr = scan_KTfrag(lds, lane, ks, 32 * wid + 16 * i);
        bf16x8 o;
        o[0] = (short)f2bf(bf2f((bf16)kr[0]) * f0[0]); o[1] = (short)f2bf(bf2f((bf16)kr[1]) * f0[1]); o[2] = (short)f2bf(bf2f((bf16)kr[2]) * f0[2]); o[3] = (short)f2bf(bf2f((bf16)kr[3]) * f0[3]);
        o[4] = (short)f2bf(bf2f((bf16)kr[4]) * f1[0]); o[5] = (short)f2bf(bf2f((bf16)kr[5]) * f1[1]); o[6] = (short)f2bf(bf2f((bf16)kr[6]) * f1[2]); o[7] = (short)f2bf(bf2f((bf16)kr[7]) * f1[3]);
        ak[i] = o;
      }
#pragma unroll
      for (int j = 0; j < 5; ++j) {
        const bf16x8 bv = scan_Vfrag(lds, lane, ks, j);
#pragma unroll
        for (int i = 0; i < 2; ++i) st[i][j] = mfma16(bv, ak[i], st[i][j]);
      }
    }
    m = m_new;
    __syncthreads();
  }
}

template <bool HG>
DEVI void gla_item(const Params& p, int item, char* lds) {
  const int pf = p.flags >> 8;
  unsigned char* ws = p.ws;
  const bf16* Z = (const bf16*)(ws + WS_Z);
  bf16* hraw = (bf16*)(ws + WS_HRAW);
  constexpr int ZLD = HG ? ZLD1 : ZLD0;
  const int tid = threadIdx.x, lane = tid & 63, wid = tid >> 6;
  int b, h, vs;
  if (HG) { b = item >> 4; h = (item >> 1) & 7; vs = item & 1; } else { b = item >> 4; h = (item >> 2) & 3; vs = item & 3; }
  const int vcol = HG ? 2048 + h * 128 + vs * 64 : 4096 + h * 256 + vs * 64;
  const int ocol = HG ? h * 128 + vs * 64 : 1024 + h * 256 + vs * 64;
  const int img_base = HG ? (b * 8 + h) * 33 : 528 + (b * 4 + h) * 33;
  const unsigned char* img0 = ws + WS_PQK + (size_t)img_base * 32768;
  const float* vec0 = (const float*)(ws + WS_PVEC) + (size_t)img_base * 384;
  const bf16* vbase = Z + (size_t)(b * T) * ZLD + vcol;
  const int dk0 = 32 * wid + (lane & 15);
  f32x4 st[2][4];
#pragma unroll
  for (int i = 0; i < 2; ++i)
#pragma unroll
    for (int j = 0; j < 4; ++j) st[i][j] = (f32x4){0.f, 0.f, 0.f, 0.f};
  ScanPre pr; float vg[2], ve[2], vd[2];
  scan_prefetch(pr, img0, vbase, ZLD, 16, tid);
#pragma unroll
  for (int i = 0; i < 2; ++i) { vg[i] = vec0[dk0 + 16 * i]; ve[i] = vec0[128 + dk0 + 16 * i]; vd[i] = vec0[256 + dk0 + 16 * i]; }
  for (int c = 0; c < 33; ++c) {
    const int L = c == 0 ? 16 : 64, t0 = c == 0 ? 0 : 16 + 64 * (c - 1);
    const int row0 = b * T + t0;
    scan_store(pr, lds, tid);
    const float gr0 = vg[0], gr1 = vg[1], e20 = ve[0], e21 = ve[1], dc0 = vd[0], dc1 = vd[1];
    __syncthreads();
    if (c + 1 < 33) {
      const int t1 = 16 + 64 * c;
      scan_prefetch(pr, img0 + (size_t)(c + 1) * 32768, vbase + (size_t)t1 * ZLD, ZLD, 64, tid);
      const float* vec = vec0 + (size_t)(c + 1) * 384;
#pragma unroll
      for (int i = 0; i < 2; ++i) { vg[i] = vec[dk0 + 16 * i]; ve[i] = vec[128 + dk0 + 16 * i]; vd[i] = vec[256 + dk0 + 16 * i]; }
    }
    if (!(pf & 1)) scan_CT_write<4>(lds, wid, lane, st, gr0, gr1);
    bf16x8 aq[4]; f32x4 accS[4];
    scan_S(lds, wid, lane, aq, accS);
    const int t = 16 * wid + (lane & 15), g = lane >> 4;
#pragma unroll
    for (int j = 0; j < 4; ++j) {
      float v[4];
#pragma unroll
      for (int r = 0; r < 4; ++r) { const int s = 16 * j + 4 * g + r; v[r] = s <= t ? accS[j][r] : 0.f; }
      scan_PM_write(lds, wid, lane, j, v);
    }
    __syncthreads();
    {
      f32x4 o1[4];
#pragma unroll
      for (int j = 0; j < 4; ++j) o1[j] = (f32x4){0.f, 0.f, 0.f, 0.f};
      if (!(pf & 2)) { scan_PV<4>(lds, wid, lane, o1);
      scan_QC<4>(lds, lane, aq, o1); }
      if (t < L) {
        bf16* dst = hraw + (size_t)(row0 + t) * D + ocol + 4 * g;
#pragma unroll
        for (int j = 0; j < 4; ++j) { u32x2 o; o.x = pk2(o1[j][0], o1[j][1]); o.y = pk2(o1[j][2], o1[j][3]); *(u32x2*)(dst + 16 * j) = o; }
      }
    }
    {
      f32x4 fr[2][4];
#pragma unroll
      for (int i = 0; i < 2; ++i)
#pragma unroll
        for (int j = 0; j < 4; ++j) fr[i][j] = (f32x4){0.f, 0.f, 0.f, 0.f};
      if (!(pf & 4))
#pragma unroll
      for (int ks = 0; ks < 2; ++ks) {
        bf16x8 ak[2];
#pragma unroll
        for (int i = 0; i < 2; ++i) ak[i] = scan_KTfrag(lds, lane, ks, 32 * wid + 16 * i);
#pragma unroll
        for (int j = 0; j < 4; ++j) {
          const bf16x8 bv = scan_Vfrag(lds, lane, ks, j);
#pragma unroll
          for (int i = 0; i < 2; ++i) fr[i][j] = mfma16(bv, ak[i], fr[i][j]);
        }
      }
#pragma unroll
      for (int j = 0; j < 4; ++j) { st[0][j] = st[0][j] * dc0 + fr[0][j] * e20; st[1][j] = st[1][j] * dc1 + fr[1][j] * e21; }
    }
    __syncthreads();
  }
}

template <bool L1>
DEVI void yfin_rows(const Params& p, int rowfirst, int rowstride, int rowend) {
  unsigned char* ws = p.ws;
  const bf16* Z = (const bf16*)(ws + WS_Z);
  const bf16* hraw = (const bf16*)(ws + WS_HRAW);
  bf16* Y = (bf16*)(ws + WS_Y);
  const int lane = threadIdx.x & 63;
  constexpr int NJ = L1 ? 2 : 4;
  for (int row0 = rowfirst; row0 < rowend; row0 += 2 * rowstride) {
    u32x4 hv[2][NJ], gv[2][NJ];
#pragma unroll
    for (int q = 0; q < 2; ++q) {
      int row = row0 + q * rowstride; row = row < rowend ? row : rowfirst;
#pragma unroll
      for (int j = 0; j < NJ; ++j) {
        const int col = 8 * lane + 512 * j;
        hv[q][j] = *(const u32x4*)(hraw + (size_t)row * D + col);
        const bf16* gsrc;
        if (L1) gsrc = Z + (size_t)row * ZLD1 + 3072 + col;
        else if (col < 1024) gsrc = Z + (size_t)row * ZLD0 + 2048 + col;
        else gsrc = Z + (size_t)row * ZLD0 + 5120 + (col - 1024);
        gv[q][j] = *(const u32x4*)gsrc;
      }
    }
#pragma unroll
    for (int q = 0; q < 2; ++q) {
      const int row = row0 + q * rowstride;
      if (row < rowend) {
#pragma unroll
        for (int j = 0; j < NJ; ++j) {
          const int col = 8 * lane + 512 * j;
          const u32x4 h4 = hv[q][j], g4 = gv[q][j];
          float x[8] = {bflo(h4.x), bfhi(h4.x), bflo(h4.y), bfhi(h4.y), bflo(h4.z), bfhi(h4.z), bflo(h4.w), bfhi(h4.w)};
          float ss = 0.f;
#pragma unroll
          for (int e = 0; e < 8; ++e) ss += x[e] * x[e];
          ss += __shfl_xor(ss, 1); ss += __shfl_xor(ss, 2); ss += __shfl_xor(ss, 4); ss += __shfl_xor(ss, 8);
          if (!L1) ss += __shfl_xor(ss, 16);
          const float rs = rsqrtf(ss * (L1 ? 1.f / 128.f : 1.f / 256.f) + EPS);
          const bool silu_gate = !L1 && col >= 1024;
          const float* gn = L1 ? p.in[16] + col : (col < 1024 ? p.in[8] + col : p.in[11] + (col - 1024));
          const float gt[8] = {bflo(g4.x), bfhi(g4.x), bflo(g4.y), bfhi(g4.y), bflo(g4.z), bfhi(g4.z), bflo(g4.w), bfhi(g4.w)};
          const f32x4 n0 = *(const f32x4*)gn, n1 = *(const f32x4*)(gn + 4);
          const float nn[8] = {n0[0], n0[1], n0[2], n0[3], n1[0], n1[1], n1[2], n1[3]};
          float y[8];
#pragma unroll
          for (int e = 0; e < 8; ++e) { const float gg = silu_gate ? siluf_(gt[e]) : sigmoidf_(gt[e]); y[e] = gg * x[e] * rs * nn[e]; }
          u32x4 o; o.x = pk2(y[0], y[1]); o.y = pk2(y[2], y[3]); o.z = pk2(y[4], y[5]); o.w = pk2(y[6], y[7]);
          *(u32x4*)(Y + (size_t)row * D + col) = o;
        }
      }
    }
  }
}


constexpr float QSCALE = 0.10411755f;
DEVI void rope_cs(float pos, int i, float& c, float& s) {
  const float inv = exp2f(-0.41524101186092029f * (float)i);
  const float ang = pos * inv;
  const float n = rintf(ang * 0.15915494309189535f);
  const float r = (float)((double)ang - (double)n * 6.283185307179586);
  c = __cosf(r); s = __sinf(r);
}
DEVI void rope_cs_f32(float pos, int i, float& c, float& s) {
  const float inv = __builtin_amdgcn_exp2f(-0.41524101186092029f * (float)i);
  const float ang = pos * inv;
  const float n = rintf(ang * 0.15915494309189535f);
  float r = fmaf(-n, 6.28125f, ang); r = fmaf(-n, 1.9353071795864769e-3f, r);
  c = __cosf(r); s = __sinf(r);
}
DEVI void mla_row_stats(const Params& p, int vb, int G) {
  unsigned char* ws = p.ws;
  const bf16* Z = (const bf16*)(ws + WS_Z);
  float* st = (float*)(ws + WS_RSTD) + 3 * MPAD;
  const int lane = threadIdx.x & 63, wid = threadIdx.x >> 6, l16 = lane & 15, rsub = lane >> 4;
  for (int row = (vb * 4 + wid) * 4 + rsub; row < NTOK; row += G * 16) {
    const bf16* zr = Z + (size_t)row * ZLD1;
    float ssq = 0.f, sskv = 0.f;
#pragma unroll
    for (int i = 0; i < 4; ++i) { const u32x4 u = *(const u32x4*)(zr + 4096 + 32 * l16 + 8 * i);
      const float a0 = bflo(u.x), a1 = bfhi(u.x), a2 = bflo(u.y), a3 = bfhi(u.y), a4 = bflo(u.z), a5 = bfhi(u.z), a6 = bflo(u.w), a7 = bfhi(u.w);
      ssq += (a0 * a0 + a1 * a1) + (a2 * a2 + a3 * a3) + (a4 * a4 + a5 * a5) + (a6 * a6 + a7 * a7); }
#pragma unroll
    for (int i = 0; i < 2; ++i) { const u32x4 u = *(const u32x4*)(zr + 4608 + 16 * l16 + 8 * i);
      const float a0 = bflo(u.x), a1 = bfhi(u.x), a2 = bflo(u.y), a3 = bfhi(u.y), a4 = bflo(u.z), a5 = bfhi(u.z), a6 = bflo(u.w), a7 = bfhi(u.w);
      sskv += (a0 * a0 + a1 * a1) + (a2 * a2 + a3 * a3) + (a4 * a4 + a5 * a5) + (a6 * a6 + a7 * a7); }
    const u32x2 kru = *(const u32x2*)(zr + 4864 + 4 * l16);
    const float k0 = bflo(kru.x), k1 = bfhi(kru.x), k2 = bflo(kru.y), k3 = bfhi(kru.y);
    float sskr = (k0 * k0 + k1 * k1) + (k2 * k2 + k3 * k3);
#pragma unroll
    for (int d = 1; d < 16; d <<= 1) { ssq += __shfl_xor(ssq, d); sskv += __shfl_xor(sskv, d); sskr += __shfl_xor(sskr, d); }
    if (l16 == 0) { f32x4 o; o[0] = rsqrtf(ssq * (1.f / 512.f) + EPS); o[1] = rsqrtf(sskv * (1.f / 256.f) + EPS); o[2] = sskr; o[3] = 0.f; *(f32x4*)(st + (size_t)row * 4) = o; }
  }
}
DEVI void mla_prep_item(const Params& p, int item, char* lds) {
  unsigned char* ws = p.ws;
  const bf16* Z = (const bf16*)(ws + WS_Z);
  const bf16* qraw = (const bf16*)(ws + WS_QRAW);
  const bf16* kvraw = (const bf16*)(ws + WS_KVRAW);
  bf16* Qh = (bf16*)(ws + WS_QH); bf16* Kh = (bf16*)(ws + WS_KH); bf16* Vt = (bf16*)(ws + WS_VT);
  const int tid = threadIdx.x, lane = tid & 63, wid = tid >> 6, l16 = lane & 15, rsub = lane >> 4;
  const int hh = item & 7, tt = (item >> 3) % 33, b = item / (8 * 33);
  const float* gq = p.in[21]; const float* gk = p.in[22];
  f32x4 gqn0 = *(const f32x4*)(gq + 8 * l16), gqn1 = *(const f32x4*)(gq + 8 * l16 + 4), gqr = *(const f32x4*)(gq + 128 + 4 * l16);
  f32x4 gkn0 = *(const f32x4*)(gk + 8 * l16), gkn1 = *(const f32x4*)(gk + 8 * l16 + 4), gkr = *(const f32x4*)(gk + 128 + 4 * l16);
  f32x4 stv_[4]; u32x2 kru_[4]; u32x4 un_[4], uv_[4];
#pragma unroll
  for (int iter = 0; iter < 4; ++iter) {
    const int tl = 16 * wid + 4 * iter + rsub, t = 64 * tt + tl;
    const int row = b * T + (t < T ? t : T - 1);
    const bf16* zr = Z + (size_t)row * ZLD1;
    stv_[iter] = *(const f32x4*)((const float*)(ws + WS_RSTD) + 3 * MPAD + (size_t)row * 4);
    kru_[iter] = *(const u32x2*)(zr + 4864 + 4 * l16);
    un_[iter] = *(const u32x4*)(kvraw + (size_t)row * 2048 + hh * 256 + 8 * l16);
    uv_[iter] = *(const u32x4*)(kvraw + (size_t)row * 2048 + hh * 256 + 128 + 8 * l16);
  }
  __builtin_amdgcn_sched_barrier(0);
#pragma unroll
  for (int iter = 0; iter < 4; ++iter) {
    const int tl = 16 * wid + 4 * iter + rsub, t = 64 * tt + tl;
    const bool valid = t < T;
    const f32x4 stv = stv_[iter];
    const float rckv = stv[1], sskr = stv[2];
    const u32x2 kru = kru_[iter];
    float kr[4] = {bflo(kru.x), bfhi(kru.x), bflo(kru.y), bfhi(kru.y)};
    float cs_[4], sn_[4];
#pragma unroll
    for (int e = 0; e < 4; ++e) rope_cs_f32((float)t, (4 * l16 + e) & 31, cs_[e], sn_[e]);
    const bool first_half = l16 < 8;
    const size_t orow = ((size_t)(b * 8 + hh) * TP + t) * 192;
    {
      const u32x4 un = un_[iter];
      const u32x4 uv = uv_[iter];
      float kn[8] = {bflo(un.x) * rckv, bfhi(un.x) * rckv, bflo(un.y) * rckv, bfhi(un.y) * rckv, bflo(un.z) * rckv, bfhi(un.z) * rckv, bflo(un.w) * rckv, bfhi(un.w) * rckv};
      float ss = 0.f;
#pragma unroll
      for (int e = 0; e < 8; ++e) ss += kn[e] * kn[e];
#pragma unroll
      for (int d = 1; d < 16; d <<= 1) ss += __shfl_xor(ss, d);
      const float rk = rsqrtf((ss + sskr) * (1.f / 192.f) + EPS) * (valid ? 1.f : 0.f);
      u32x4 on; on.x = pk2(kn[0] * rk * gkn0[0], kn[1] * rk * gkn0[1]); on.y = pk2(kn[2] * rk * gkn0[2], kn[3] * rk * gkn0[3]);
      on.z = pk2(kn[4] * rk * gkn1[0], kn[5] * rk * gkn1[1]); on.w = pk2(kn[6] * rk * gkn1[2], kn[7] * rk * gkn1[3]);
      float ro[4];
#pragma unroll
      for (int e = 0; e < 4; ++e) {
        const float mine = kr[e] * rk * gkr[e];
        const float other = __shfl_xor(mine, 8);
        ro[e] = first_half ? (mine * cs_[e] - other * sn_[e]) : (other * sn_[e] + mine * cs_[e]);
      }
      u32x2 orr; orr.x = pk2(ro[0], ro[1]); orr.y = pk2(ro[2], ro[3]);
      if (t < TP) { *(u32x4*)(Kh + orow + 8 * l16) = on; *(u32x2*)(Kh + orow + 128 + 4 * l16) = orr; }
      const float vsc = valid ? rckv : 0.f;
      const float vv[8] = {bflo(uv.x) * vsc, bfhi(uv.x) * vsc, bflo(uv.y) * vsc, bfhi(uv.y) * vsc, bflo(uv.z) * vsc, bfhi(uv.z) * vsc, bflo(uv.w) * vsc, bfhi(uv.w) * vsc};
      const int x = tl & 15, pos = (tl & ~15) + 8 * ((x >> 2) & 1) + 4 * (x >> 3) + (x & 3);
#pragma unroll
      for (int e = 0; e < 8; ++e) *(bf16*)(lds + (8 * l16 + e) * 128 + pos * 2) = (bf16)f2bf(vv[e]);
    }
  }
  __syncthreads();
  {
    const int v = tid >> 1, half = tid & 1;
    bf16* dst = Vt + ((size_t)(b * 8 + hh) * 128 + v) * TP + 64 * tt + 32 * half;
    const char* s = lds + v * 128 + 64 * half;
#pragma unroll
    for (int i = 0; i < 4; ++i) *(u32x4*)(dst + 8 * i) = *(const u32x4*)(s + 16 * i);
  }
  __syncthreads();
}

DEVI void attn_item(const Params& p, int b, int hh, int qb, char* lds) {
  unsigned char* ws = p.ws;
  const bf16* Qh = (const bf16*)(ws + WS_QH); const bf16* Kh = (const bf16*)(ws + WS_KH); const bf16* Vt = (const bf16*)(ws + WS_VT);
  bf16* Y = (bf16*)(ws + WS_Y);
  const int tid = threadIdx.x, lane = tid & 63, wid = tid >> 6, l31 = lane & 31, hf = lane >> 5;
  const int tq = 128 * qb + 32 * wid + l31;
  const size_t bh = (size_t)(b * 8 + hh);
  bf16x8 qf[12];
  {
    const int tql = tq < T ? tq : T - 1;
    const int row = b * T + tql;
    const bf16* qp = (const bf16*)(ws + WS_QRAW) + (size_t)row * 1536 + hh * 192 + 8 * hf;
    const float rcq = ((const float*)(ws + WS_RSTD) + 3 * MPAD)[(size_t)row * 4];
#define raw(s_) (__builtin_bit_cast(u32x4, qf[s_]))
#pragma unroll
    for (int s = 0; s < 12; ++s) qf[s] = u4_as_b8(*(const u32x4*)(qp + 16 * s));
    float ss = 0.f;
#pragma unroll
    for (int s = 0; s < 12; ++s) {
      const float a0 = bflo(raw(s).x), a1 = bfhi(raw(s).x), a2 = bflo(raw(s).y), a3 = bfhi(raw(s).y), a4 = bflo(raw(s).z), a5 = bfhi(raw(s).z), a6 = bflo(raw(s).w), a7 = bfhi(raw(s).w);
      ss += (a0 * a0 + a1 * a1) + (a2 * a2 + a3 * a3) + (a4 * a4 + a5 * a5) + (a6 * a6 + a7 * a7);
    }
    ss += __shfl_xor(ss, 32);
    const float sc = rsqrtf(ss * rcq * rcq * (1.f / 192.f) + EPS) * rcq * QSCALE;
    const float* gq = p.in[21];
#pragma unroll
    for (int s = 0; s < 8; ++s) {
      const f32x4 g0 = *(const f32x4*)(gq + 16 * s + 8 * hf), g1 = *(const f32x4*)(gq + 16 * s + 8 * hf + 4);
      u32x4 o; o.x = pk2(bflo(raw(s).x) * sc * g0[0], bfhi(raw(s).x) * sc * g0[1]); o.y = pk2(bflo(raw(s).y) * sc * g0[2], bfhi(raw(s).y) * sc * g0[3]);
      o.z = pk2(bflo(raw(s).z) * sc * g1[0], bfhi(raw(s).z) * sc * g1[1]); o.w = pk2(bflo(raw(s).w) * sc * g1[2], bfhi(raw(s).w) * sc * g1[3]);
      qf[s] = u4_as_b8(o);
      if (s & 1) __builtin_amdgcn_sched_barrier(0);
    }
#pragma unroll
    for (int a = 0; a < 2; ++a) {
      float u1[8], u2[8];
      {
        const f32x4 g0 = *(const f32x4*)(gq + 128 + 16 * a + 8 * hf), g1 = *(const f32x4*)(gq + 128 + 16 * a + 8 * hf + 4);
        const u32x4 r1 = raw(8 + a);
        u1[0] = bflo(r1.x) * sc * g0[0]; u1[1] = bfhi(r1.x) * sc * g0[1]; u1[2] = bflo(r1.y) * sc * g0[2]; u1[3] = bfhi(r1.y) * sc * g0[3];
        u1[4] = bflo(r1.z) * sc * g1[0]; u1[5] = bfhi(r1.z) * sc * g1[1]; u1[6] = bflo(r1.w) * sc * g1[2]; u1[7] = bfhi(r1.w) * sc * g1[3];
        const f32x4 h0 = *(const f32x4*)(gq + 160 + 16 * a + 8 * hf), h1 = *(const f32x4*)(gq + 160 + 16 * a + 8 * hf + 4);
        const u32x4 r2 = raw(10 + a);
        u2[0] = bflo(r2.x) * sc * h0[0]; u2[1] = bfhi(r2.x) * sc * h0[1]; u2[2] = bflo(r2.y) * sc * h0[2]; u2[3] = bfhi(r2.y) * sc * h0[3];
        u2[4] = bflo(r2.z) * sc * h1[0]; u2[5] = bfhi(r2.z) * sc * h1[1]; u2[6] = bflo(r2.w) * sc * h1[2]; u2[7] = bfhi(r2.w) * sc * h1[3];
      }
      float o1[8], o2[8];
#pragma unroll
      for (int j = 0; j < 8; ++j) { float cs, sn; rope_cs_f32((float)tql, 16 * a + 8 * hf + j, cs, sn); o1[j] = u1[j] * cs - u2[j] * sn; o2[j] = u1[j] * sn + u2[j] * cs; }
      u32x4 w1, w2;
      w1.x = pk2(o1[0], o1[1]); w1.y = pk2(o1[2], o1[3]); w1.z = pk2(o1[4], o1[5]); w1.w = pk2(o1[6], o1[7]);
      w2.x = pk2(o2[0], o2[1]); w2.y = pk2(o2[2], o2[3]); w2.z = pk2(o2[4], o2[5]); w2.w = pk2(o2[6], o2[7]);
      qf[8 + a] = u4_as_b8(w1); qf[10 + a] = u4_as_b8(w2);
      __builtin_amdgcn_sched_barrier(0);
    }
  }
#undef raw
  f32x16 oacc[4];
#pragma unroll
  for (int v = 0; v < 4; ++v)
#pragma unroll
    for (int r = 0; r < 16; ++r) oacc[v][r] = 0.f;
  float m_run = -1e30f, l_run = 0.f;
  int nkt = 2 * qb + 2; if (nkt > 33) nkt = 33;
  char* VT = lds + 49152;
  const bf16* kbase = Kh + bh * TP * 192;
  const bf16* vbase = Vt + bh * 128 * TP;
  int ksrc[3];
#pragma unroll
  for (int j = 0; j < 3; ++j) { const int X = j * 256 + tid, r = X / 24, cp = X - 24 * r, c = (cp & ~7) | ((cp & 7) ^ ((r >> 1) & 7)); ksrc[j] = r * 192 + 8 * c; }
#define A_KDMA(kt_, buf_) do { _Pragma("unroll") for (int j = 0; j < 6; ++j) \
      __builtin_amdgcn_global_load_lds((const unsigned*)(kbase + (size_t)(64 * (kt_) + (j >= 3 ? 32 : 0)) * 192 + ksrc[j % 3]), (LAS unsigned*)(lds + (buf_) * 24576 + (4 * j + wid) * 1024), 16, 0, 0); } while (0)
  int vsrc0;
  { const int v_ = tid >> 3, cp = tid & 7, c = cp ^ ((v_ >> 1) & 7); vsrc0 = v_ * TP + 8 * c; }
#define A_VDMA(kt_) do { _Pragma("unroll") for (int j = 0; j < 4; ++j) \
      __builtin_amdgcn_global_load_lds((const unsigned*)(vbase + 64 * (kt_) + (size_t)(32 * j) * TP + vsrc0), (LAS unsigned*)(lds + 49152 + (4 * j + wid) * 1024), 16, 0, 0); } while (0)
  A_KDMA(0, 0);
  for (int kt = 0; kt < nkt; ++kt) {
    const char* KT = lds + (kt & 1) * 24576;
    asm volatile("s_waitcnt vmcnt(0)" ::: "memory");
    __syncthreads();
    A_VDMA(kt);
    { const int kn = kt + 1 < nkt ? kt + 1 : kt; A_KDMA(kn, (kt + 1) & 1); }
    __builtin_amdgcn_sched_barrier(0);
    const bool active = 64 * kt <= 128 * qb + 32 * wid + 31;
    bf16x8 pb[4];
    float alpha = 1.f;
    if (active) {
      f32x16 sacc[2];
#pragma unroll
      for (int i = 0; i < 2; ++i)
#pragma unroll
        for (int r = 0; r < 16; ++r) sacc[i][r] = 0.f;
#pragma unroll
      for (int s = 0; s < 12; ++s) {
        const int c = 2 * s + hf;
#pragma unroll
        for (int i = 0; i < 2; ++i) {
          const int r = 32 * i + l31;
          const bf16x8 a = *(const bf16x8*)(KT + r * 384 + (((c & ~7) | ((c & 7) ^ ((r >> 1) & 7))) << 4));
          sacc[i] = mfma32(a, qf[s], sacc[i]);
        }
      }
      if (64 * kt + 63 > 128 * qb + 32 * wid) {
#pragma unroll
        for (int i = 0; i < 2; ++i)
#pragma unroll
          for (int r = 0; r < 16; ++r) { const int key = 64 * kt + 32 * i + (r & 3) + 8 * (r >> 2) + 4 * hf; if (key > tq) sacc[i][r] = -1e30f; }
      }
      float mx = -1e30f;
#pragma unroll
      for (int i = 0; i < 2; ++i)
#pragma unroll
        for (int r = 0; r < 16; ++r) mx = fmaxf(mx, sacc[i][r]);
      mx = fmaxf(mx, __shfl_xor(mx, 32));
      const float m_new = fmaxf(m_run, mx);
      alpha = __builtin_amdgcn_exp2f(m_run - m_new);
      float psum = 0.f;
#pragma unroll
      for (int i = 0; i < 2; ++i)
#pragma unroll
        for (int r = 0; r < 16; ++r) { const float pv = __builtin_amdgcn_exp2f(sacc[i][r] - m_new); sacc[i][r] = pv; psum += pv; }
      psum += __shfl_xor(psum, 32);
      l_run = l_run * alpha + psum; m_run = m_new;
#pragma unroll
      for (int ks = 0; ks < 4; ++ks) {
        const int i = ks >> 1, s0 = 8 * (ks & 1);
        u32x4 pu; pu.x = pk2(sacc[i][s0 + 0], sacc[i][s0 + 1]); pu.y = pk2(sacc[i][s0 + 2], sacc[i][s0 + 3]); pu.z = pk2(sacc[i][s0 + 4], sacc[i][s0 + 5]); pu.w = pk2(sacc[i][s0 + 6], sacc[i][s0 + 7]);
        pb[ks] = u4_as_b8(pu);
      }
    } else {
#pragma unroll
      for (int ks = 0; ks < 4; ++ks) pb[ks] = u4_as_b8((u32x4){0u, 0u, 0u, 0u});
    }
    asm volatile("s_waitcnt vmcnt(0)" ::: "memory");
    __syncthreads();
    if (active) {
#pragma unroll
      for (int v = 0; v < 4; ++v)
#pragma unroll
        for (int r = 0; r < 16; ++r) oacc[v][r] *= alpha;
#pragma unroll
      for (int ks = 0; ks < 4; ++ks) {
        const int c = 2 * ks + hf;
#pragma unroll
        for (int v = 0; v < 4; ++v) {
          const int r = 32 * v + l31;
          const bf16x8 a = *(const bf16x8*)(VT + r * 128 + ((c ^ ((r >> 1) & 7)) << 4));
          oacc[v] = mfma32(a, pb[ks], oacc[v]);
        }
      }
    }
  }
  __syncthreads();
#undef A_KDMA
#undef A_VDMA
  if (tq < T) {
    const float inv = 1.f / l_run;
    bf16* dst = Y + (size_t)(b * T + tq) * D + 1024 + hh * 128 + 4 * hf;
#pragma unroll
    for (int v = 0; v < 4; ++v)
#pragma unroll
      for (int q4 = 0; q4 < 4; ++q4) {
        u32x2 o; o.x = pk2(oacc[v][4 * q4 + 0] * inv, oacc[v][4 * q4 + 1] * inv); o.y = pk2(oacc[v][4 * q4 + 2] * inv, oacc[v][4 * q4 + 3] * inv);
        *(u32x2*)(dst + 32 * v + 8 * q4) = o;
      }
  }
}

struct MoeSrc1 {
  const Params& p; int layer; const int* ioff; const int* itp; const int* icnt; const int* emap;
  DEVI void locate(int L, int& e, int& mt, int& nt, int& nvalid) const {
    const int mtg = L >> 3; nt = L & 7; e = emap[mtg];
    mt = mtg - itp[e]; nvalid = icnt[e] - mt * 128; if (nvalid > 128) nvalid = 128;
  }
  DEVI void tile(int L, TileDesc& d) const {
    int e, mt, nt, nvalid; locate(L, e, mt, nt, nvalid);
    unsigned char* ws = p.ws;
    d.A = (const bf16*)(ws + WS_XN); d.lda = D; d.rows = (const int*)(ws + WS_LIST) + (size_t)e * NTOK + mt * 128; d.nvalid = nvalid; d.arow0 = 0;
    d.Bt = (const bf16*)(ws + (layer ? WS_W13B : WS_W13)) + ((size_t)e * 1024 + nt * 128) * 2048; d.ldb = 2048; d.K = 2048;
  }
  DEVI void epilogue(int L, const f32x4 (&acc)[4][4], int wm, int wn, int lane) const {
    int e, mt, nt, nvalid; locate(L, e, mt, nt, nvalid);
    unsigned char* ws = p.ws;
    EpiMoe1 epi{(bf16*)(ws + WS_HBUF), (const int*)(ws + WS_LIST) + (size_t)e * NTOK + mt * 128, (const float*)(ws + WS_RSTD) + 2 * MPAD, nvalid, ioff[e] + mt * 128, nt * 64};
    epi(acc, wm, wn, lane);
  }
};
struct MoeSrc2 {
  const Params& p; int layer; const int* ioff; const int* itp; const int* icnt; const int* emap;
  DEVI void locate(int L, int& e, int& mt, int& nt, int& nvalid) const {
    const int mtg = L >> 4; nt = L & 15; e = emap[mtg];
    mt = mtg - itp[e]; nvalid = icnt[e] - mt * 128; if (nvalid > 128) nvalid = 128;
  }
  DEVI void tile(int L, TileDesc& d) const {
    int e, mt, nt, nvalid; locate(L, e, mt, nt, nvalid);
    unsigned char* ws = p.ws;
    d.A = (const bf16*)(ws + WS_HBUF); d.lda = 512; d.rows = nullptr; d.nvalid = 128; d.arow0 = ioff[e] + mt * 128;
    d.Bt = (const bf16*)(ws + (layer ? WS_W2B : WS_W2)) + ((size_t)e * 2048 + nt * 128) * 512; d.ldb = 512; d.K = 512;
  }
  DEVI void epilogue(int L, const f32x4 (&acc)[4][4], int wm, int wn, int lane) const {
    int e, mt, nt, nvalid; locate(L, e, mt, nt, nvalid);
    unsigned char* ws = p.ws;
    EpiMoe2 epi{(bf16*)(ws + WS_YMOE), (const float*)(ws + WS_GLIST) + (size_t)e * NTOK + mt * 128, nvalid, ioff[e] + mt * 128, nt * 128};
    epi(acc, wm, wn, lane);
  }
};
struct MoeSrc1Half {
  const Params& p; int layer; const int* ioff; const int* itp; const int* icnt; const int* emap; int full;
  DEVI void locate(int it, int& hb, int& e, int& mt, int& nt, int& nvalid) const {
    const int L = full + (it >> 1); hb = it & 1;
    const int mtg = L >> 3; nt = L & 7; e = emap[mtg];
    mt = mtg - itp[e]; nvalid = icnt[e] - mt * 128; if (nvalid > 128) nvalid = 128;
  }
  DEVI void tile(int it, TileDesc& d) const {
    int hb, e, mt, nt, nvalid; locate(it, hb, e, mt, nt, nvalid);
    unsigned char* ws = p.ws;
    d.A = (const bf16*)(ws + WS_XN); d.lda = D; d.rows = (const int*)(ws + WS_LIST) + (size_t)e * NTOK + mt * 128; d.nvalid = nvalid; d.arow0 = 0;
    d.Bt = (const bf16*)(ws + (layer ? WS_W13B : WS_W13)) + ((size_t)e * 1024 + nt * 128 + hb * 64) * 2048; d.ldb = 2048; d.K = 2048;
  }
  DEVI void epilogue_half(int it, const f32x4 (&acc)[2][4], int wid, int lane) const {
    int hb, e, mt, nt, nvalid; locate(it, hb, e, mt, nt, nvalid);
    unsigned char* ws = p.ws;
    const int* rows = (const int*)(ws + WS_LIST) + (size_t)e * NTOK + mt * 128;
    const float* rs = (const float*)(ws + WS_RSTD) + 2 * MPAD;
    bf16* hb_ = (bf16*)(ws + WS_HBUF);
    const int slot0 = ioff[e] + mt * 128, c0 = nt * 64 + hb * 32;
    float sv[2];
#pragma unroll
    for (int i = 0; i < 2; ++i) { const int rl = wid * 32 + 16 * i + (lane & 15); sv[i] = rs[rows[rl < nvalid ? rl : nvalid - 1]]; }
#pragma unroll
    for (int i = 0; i < 2; ++i) {
      const int rl = wid * 32 + 16 * i + (lane & 15);
      if (rl < nvalid) {
        const float s = sv[i];
        f32x4 v0, v1;
#pragma unroll
        for (int r = 0; r < 4; ++r) { v0[r] = siluf_(acc[i][0][r] * s) * (acc[i][1][r] * s); v1[r] = siluf_(acc[i][2][r] * s) * (acc[i][3][r] * s); }
        u32x4 w; wide_pair(v0, v1, 1.f, w);
        const int g = lane >> 4;
        *(u32x4*)(hb_ + (size_t)(slot0 + rl) * 512 + c0 + 16 * (g & 1) + 4 * (g & 2)) = w;
      }
    }
  }
};
DEVI void moe_gemm1(const Params& p, int layer, int vb, int G, char* lds) {
  unsigned char* ws = p.ws;
  int* ioff = (int*)(lds + 65536); int* itp = ioff + 40; int* icnt = itp + 40; int* emap = icnt + 40;
  moe_offsets((const int*)(ws + WS_CTL) + CT_CNT + layer * NE * CSTR, ioff, itp, icnt, emap);
  const int total = itp[NE] * 8, full = (total / G) * G, rem = total - full;
  MoeSrc1 src{p, layer, ioff, itp, icnt, emap};
  gemm_loop(src, vb, G, full, lds);
  if (rem > 0) {
    const int tmap = (((vb & 63) >> 3) * 8 + (vb >> 6)) * 8 + (vb & 7);
    MoeSrc1Half hs{p, layer, ioff, itp, icnt, emap, full}; gemm_loop_half(hs, G == 512 ? tmap : vb, G, rem * 2, lds); }
}
DEVI void moe_gemm2(const Params& p, int layer, int vb, int G, char* lds) {
  unsigned char* ws = p.ws;
  int* ioff = (int*)(lds + 65536); int* itp = ioff + 40; int* icnt = itp + 40; int* emap = icnt + 40;
  moe_offsets((const int*)(ws + WS_CTL) + CT_CNT + layer * NE * CSTR, ioff, itp, icnt, emap);
  MoeSrc2 src{p, layer, ioff, itp, icnt, emap};
  gemm_loop(src, vb, G, itp[NE] * 16, lds);
}

constexpr int NPHASE = 20;
__global__ void __launch_bounds__(NTHR, 2) mega(Params p) {
  extern __shared__ __attribute__((aligned(16))) char lds[];
  cg::grid_group grid = cg::this_grid();
  const int G = gridDim.x, bx = blockIdx.x, vb = vcu_of(bx, G);
  unsigned char* ws = p.ws;
  float* rstd = (float*)(ws + WS_RSTD);
  const int lo = p.ph_lo, hi = p.ph_hi;
  volatile LAS unsigned* xst = (volatile LAS unsigned*)(LAS char*)(lds + LDS_BYTES - 64);
  if (threadIdx.x < 2) xst[threadIdx.x] = 0u;
  __syncthreads();
  XcdBarrier xbar; xbar.bar = (unsigned*)(ws + WS_CTL) + CT_BAR; xbar.x = 0; xbar.st = xst;
  if (hi - lo > 1) xbar = xcd_barrier_post((unsigned*)(ws + WS_CTL) + CT_BAR, xst);
#ifdef ONLY
#define IN(k) ((k) == ONLY && lo <= (k) && (k) < hi)
#else
#define IN(k) (lo <= (k) && (k) < hi)
#endif
#ifdef USE_COOP
#define SEAM(k) do { if (IN(k) && IN((k) + 1)) { if ((k) == 0) grid.sync(); else xcd_barrier(xbar); } } while (0)
#else
#define SEAM(k) do { if (IN(k) && IN((k) + 1)) { xcd_barrier(xbar); } } while (0)
#endif
#ifdef EXTRA_SYNC
  for (int i_ = 0; i_ < EXTRA_SYNC; ++i_) xcd_barrier(xbar);
#endif
  if (IN(0)) { dense_transposes(p, vb, G, lds); pack_small(p, vb, G); }
  SEAM(0);
  if (IN(1)) rowpass2<0, 1>(p, p.in[2], rstd, (const bf16*)(ws + WS_WPK), 0, bx, G, lds);
  SEAM(1);
  if (IN(2)) inproj0_phase(p, vb, G, lds);
  SEAM(2);
  if (IN(3)) {
    int* ctr = (int*)(ws + WS_CTL) + CT_WQ + 0; int* slot = (int*)(lds + LDS_BYTES - 32);
    (void)ctr; (void)slot;
    for (int it = bx; it < 1056; it += G) { if (it < 528) gla_prep<false>(p, it, lds); else mlstm_prep(p, it - 528, lds); }
  }
  SEAM(3);
  if (IN(4)) {
    if (!(p.flags & 2)) {
    for (int it = bx; it < 64; it += G) mlstm_item(p, it, lds);
    for (int it = bx; it < 128; it += G) if (it >= 64) gla_item<false>(p, it - 64, lds);
    }
    if (!(p.flags & 1) && hi - lo > 1) { FillState fst; fst.pos = bx >= 128 ? (bx - 128) * 16 : 0; fst.end = bx >= 128 ? fst.pos + 16 : 0; fst.active = true; while (fill_step(p, lds, fst)) {} }
  }
  SEAM(4);
  if (IN(5)) yfin_rows<false>(p, bx * 4 + (threadIdx.x >> 6), G * 4, NTOK);
  SEAM(5);
  if (IN(6)) {
    outproj_phase((const bf16*)(ws + WS_Y), (const bf16*)(ws + WS_WOUT0), (bf16*)(ws + WS_H), ws, 0, vb, G, lds);
  }
  SEAM(6);
  if (IN(7)) rowpass2<2, 2>(p, p.in[24], rstd + 2 * MPAD, (const bf16*)(ws + WS_WPK + 131072), 0, bx, G, lds);
  SEAM(7);
  if (IN(8)) moe_gemm1(p, 0, vb, G, lds);
  SEAM(8);
  if (IN(9)) moe_gemm2(p, 0, vb, G, lds);
  SEAM(9);
  if (IN(10)) combine_norm(p, p.in[13], rstd + MPAD, 0, bx, G, lds);
  SEAM(10);
  if (IN(11)) {
    gemm_phase((const bf16*)(ws + WS_XN), D, (const bf16*)(ws + WS_WIN1), 2048, ZLD1, vb, G, lds,
               [&](int m0, int n0) { return EpiBf16{(bf16*)(ws + WS_Z), ZLD1, rstd + MPAD, m0, n0, NTOK}; });
  }
  SEAM(11);
  if (IN(12)) {
    mla_row_stats(p, vb, G);
    struct UpSrc { unsigned char* ws;
      DEVI void tile(int L, TileDesc& d) const {
        const int n1 = (MPAD / 128) * 12; int pm, pn;
        if (L < n1) { tile_of(L, MPAD / 128, 12, pm, pn); d.A = (const bf16*)(ws + WS_Z) + 4096; d.Bt = (const bf16*)(ws + WS_WQ) + (size_t)pn * 128 * 512; d.ldb = 512; d.K = 512; }
        else { tile_of(L - n1, MPAD / 128, 16, pm, pn); d.A = (const bf16*)(ws + WS_Z) + 4608; d.Bt = (const bf16*)(ws + WS_WKV) + (size_t)pn * 128 * 256; d.ldb = 256; d.K = 256; }
        d.lda = ZLD1; d.rows = nullptr; d.nvalid = 128; d.arow0 = pm * 128;
      }
      DEVI void epilogue(int L, const f32x4 (&acc)[4][4], int wm, int wn, int lane) const {
        const int n1 = (MPAD / 128) * 12; int pm, pn;
        if (L < n1) { tile_of(L, MPAD / 128, 12, pm, pn); EpiBf16 e{(bf16*)(ws + WS_QRAW), 1536, nullptr, pm * 128, pn * 128, NTOK}; e(acc, wm, wn, lane); }
        else { tile_of(L - n1, MPAD / 128, 16, pm, pn); EpiBf16 e{(bf16*)(ws + WS_KVRAW), 2048, nullptr, pm * 128, pn * 128, NTOK}; e(acc, wm, wn, lane); }
      } };
    UpSrc src{ws};
    gemm_loop(src, vb, G, (MPAD / 128) * 28, lds);
  }
  SEAM(12);
  if (IN(13)) {
    int* ctr = (int*)(ws + WS_CTL) + CT_WQ + 16; int* slot = (int*)(lds + LDS_BYTES - 32);
    (void)ctr; (void)slot;
    for (int it = bx; it < 1056 * 2; it += G) { if (it < 1056) mla_prep_item(p, it, lds); else gla_prep<true>(p, it - 1056, lds); }
  }
  SEAM(13);
  if (IN(14)) {
    if (!(p.flags & 2)) { for (int it = bx; it < 64; it += G) gla_item<true>(p, it, lds); }
    if (!(p.flags & 1)) { int* ctr = (int*)(ws + WS_CTL) + CT_WQ + 32; int* slot = (int*)(lds + LDS_BYTES - 32);
      if (hi - lo > 1) { for (int a = bx >= 64 ? bx - 64 : (G - 64) + next_item(ctr, slot); a < 544; a = (G - 64) + next_item(ctr, slot)) attn_item(p, (a & 31) >> 3, a & 7, 16 - (a >> 5), lds); }
      else { for (int a = bx; a < 544; a += G) attn_item(p, (a & 31) >> 3, a & 7, 16 - (a >> 5), lds); } }
  }
  SEAM(14);
  if (IN(15)) yfin_rows<true>(p, bx * 4 + (threadIdx.x >> 6), G * 4, NTOK);
  SEAM(15);
  if (IN(16)) {
    outproj_phase((const bf16*)(ws + WS_Y), (const bf16*)(ws + WS_WOUT1), (bf16*)(ws + WS_H), ws, 1, vb, G, lds);
  }
  SEAM(16);
  if (IN(17)) rowpass2<2, 2>(p, p.in[24] + D, rstd + 2 * MPAD, (const bf16*)(ws + WS_WPK + 131072 + 196608), 1, bx, G, lds);
  SEAM(17);
  if (IN(18)) moe_gemm1(p, 1, vb, G, lds);
  SEAM(18);
  if (IN(19)) moe_gemm2(p, 1, vb, G, lds);
  SEAM(19);
  if (IN(20)) final_combine(p, bx, G, lds);
#undef IN
#undef SEAM
}

#ifndef MK_MULTI
#define MK_MULTI 0
#endif
extern "C" void kernel_launch(void* const* d_in, const int* in_sizes, int n_in, void* d_out, int out_size,
                              void* d_ws, size_t ws_size, hipStream_t stream) {
  static int grid_blocks = 0;
  if (!grid_blocks) {
    int dev = 0, cus = 0, per_cu = 0;
    (void)hipGetDevice(&dev);
    (void)hipDeviceGetAttribute(&cus, hipDeviceAttributeMultiprocessorCount, dev);
    (void)hipFuncSetAttribute((const void*)mega, hipFuncAttributeMaxDynamicSharedMemorySize, LDS_BYTES);
    (void)hipOccupancyMaxActiveBlocksPerMultiprocessor(&per_cu, mega, NTHR, (size_t)LDS_BYTES);
    if (per_cu < 1) per_cu = 1;
    if (per_cu > 2) per_cu = 2;
    grid_blocks = cus * per_cu;
    if (n_in != 32 || ws_size < WS_END) fprintf(stderr, "kernel_launch: unexpected n_in %d / ws %zu (need %zu)\n", n_in, ws_size, (size_t)WS_END);
    fprintf(stderr, "mega: cus %d per_cu %d grid %d ws %zu\n", cus, per_cu, grid_blocks, ws_size);
  }
  (void)hipMemsetAsync((char*)d_ws + WS_CTL, 0, CTL_BYTES, stream);
  Params p{};
  for (int i = 0; i < 32; ++i) p.in[i] = (const float*)d_in[i];
  p.out = (float*)d_out; p.ws = (unsigned char*)d_ws;
#if MK_MULTI
  for (int ph = 0; ph <= NPHASE; ++ph) {
    p.ph_lo = ph; p.ph_hi = ph + 1;
    hipLaunchKernelGGL(mega, dim3(grid_blocks), dim3(NTHR), LDS_BYTES, stream, p);
  }
#else
  p.ph_lo = 0; p.ph_hi = NPHASE + 1;
  void* args[] = {&p};
#ifdef USE_COOP
  hipError_t e = hipLaunchCooperativeKernel((void*)mega, dim3(grid_blocks), dim3(NTHR), args, LDS_BYTES, stream);
#else
  hipLaunchKernelGGL(mega, dim3(grid_blocks), dim3(NTHR), LDS_BYTES, stream, p);
  hipError_t e = hipPeekAtLastError();
#endif
  if (e != hipSuccess) fprintf(stderr, "cooperative launch failed: %s (grid %d)\n", hipGetErrorString(e), grid_blocks);
#ifdef PROBE_PHASE
  for (int rep = 0; rep < PROBE_REPS; ++rep) {
    Params q = p; q.ph_lo = PROBE_PHASE; q.ph_hi = PROBE_PHASE + 1; q.flags = PROBE_FLAGS;
    void* args2[] = {&q};
    (void)hipLaunchCooperativeKernel((void*)mega, dim3(grid_blocks), dim3(NTHR), args2, LDS_BYTES, stream);
  }
#endif
#endif
}
```
